# Optimizing an MI355X kernel written in HIP

```python
import math
import jax, jax.numpy as jnp
from jax import lax
import numpy as np

D_MODEL = 1024
BATCH = 4
SEQ = 4096
DEPTH = 2

F32 = jnp.float32
EPS = 1e-6
MEM_LEN = 256
MAX_POS_OFFSET = 1024
SSM_WIDTH = 512
SSM_GROUP = 16
SSM_GROUPS = SSM_WIDTH // SSM_GROUP
SSM_STATE = 64
DT_MIN = 1e-3
DT_MAX = 1e-1
ATT_HEAD_DIM = 64
ATT_SLOTS = 4
DIL_PAIRS = ((128, 1), (512, 4), (2048, 16))
N_DIL = len(DIL_PAIRS)
ATT_HEADS = ATT_SLOTS * N_DIL
ATT_WIDTH = ATT_HEADS * ATT_HEAD_DIM
ATT_OUT = ATT_SLOTS * ATT_HEAD_DIM
BLOCK = 128
ROPE_THETA = 10000.0
X_HEADS = 4
X_HEAD_DIM = 128
X_WIDTH = X_HEADS * X_HEAD_DIM
N_BRANCH = 3
IN_COLS = SSM_WIDTH + 3 * ATT_WIDTH + X_WIDTH + N_BRANCH * D_MODEL
D_FF = 2816
N_EXPERTS = 8
TOP_K = 2
D_FF_EXPERT = 3584
N_DENSE = (DEPTH + 1) // 2
N_MOE = DEPTH // 2

kernel_name = 'hybrid_s5_dilated_memory_moe_block'


def rmsnorm(x, g):
    xf = x.astype(F32)
    y = xf * lax.rsqrt(jnp.mean(xf * xf, axis=-1, keepdims=True) + EPS)
    return (y * g.astype(F32)).astype(x.dtype)


def rope(x, pos):
    half = x.shape[-1] // 2
    inv = ROPE_THETA ** (-jnp.arange(half, dtype=F32) / half)
    ang = pos.astype(F32)[:, None, :, None] * inv
    cos, sin = jnp.cos(ang), jnp.sin(ang)
    xf = x.astype(F32)
    x1, x2 = xf[..., :half], xf[..., half:]
    return jnp.concatenate([x1 * cos - x2 * sin, x1 * sin + x2 * cos], axis=-1).astype(x.dtype)


def ssm_branch(u, a_re, a_im, log_dt, b_re, b_im, c_re, c_im, d_skip, w_glu):
    bsz, L, _ = u.shape
    uf = u.astype(F32).reshape(bsz, L, SSM_GROUPS, SSM_GROUP)
    lam = lax.complex(a_re.astype(F32), a_im.astype(F32))
    dt = jnp.exp(log_dt.astype(F32))[:, None]
    lam_bar = jnp.exp(lam * dt)
    b = lax.complex(b_re.astype(F32), b_im.astype(F32))
    b_bar = ((lam_bar - 1.0) / lam)[..., None] * b
    bu = jnp.einsum('blgc,gpc->blgp', uf.astype(jnp.complex64), b_bar)
    a_el = jnp.broadcast_to(lam_bar, bu.shape)

    def combine(left, right):
        a1, s1 = left
        a2, s2 = right
        return a2 * a1, a2 * s1 + s2

    _, states = lax.associative_scan(combine, (a_el, bu), axis=1)
    c = lax.complex(c_re.astype(F32), c_im.astype(F32))
    y = jnp.einsum('blgp,gcp->blgc', states, c).real \
        + d_skip.astype(F32).reshape(SSM_GROUPS, SSM_GROUP) * uf
    y = jax.nn.gelu(y.reshape(bsz, L, SSM_WIDTH))
    ga = y @ w_glu.astype(F32)
    out = ga[..., :SSM_WIDTH] * jax.nn.sigmoid(ga[..., SSM_WIDTH:])
    return out.astype(u.dtype)


def dilated_group(q, k, v, dilation, span):
    bsz, H, L, hd = q.shape
    n = L // dilation
    nb = -(-n // BLOCK)
    npad = nb * BLOCK

    def stride(t):
        t = t.reshape(bsz, H, n, dilation, hd).transpose(0, 1, 3, 2, 4)
        return jnp.pad(t, ((0, 0), (0, 0), (0, 0), (0, npad - n), (0, 0)))

    def band(t):
        tb = t.reshape(bsz, H, dilation, nb, BLOCK, hd)
        prev = jnp.pad(tb, ((0, 0), (0, 0), (0, 0), (1, 0), (0, 0), (0, 0)))[:, :, :, :nb]
        return jnp.concatenate([prev, tb], axis=4)

    qb = stride(q).reshape(bsz, H, dilation, nb, BLOCK, hd)
    kb = band(stride(k))
    vb = band(stride(v))
    s = jnp.einsum('bhrnqd,bhrnkd->bhrnqk', qb, kb).astype(F32) * (hd ** -0.5)
    qi = jnp.arange(BLOCK)[:, None] + BLOCK
    ki = jnp.arange(2 * BLOCK)[None, :]
    off = qi - ki
    blk = jnp.arange(nb)[:, None, None]
    valid = (off >= 0) & (off <= span) & (blk * BLOCK + ki - BLOCK >= 0)
    s = jnp.where(valid, s, -1e30)
    m = jnp.max(s, axis=-1, keepdims=True)
    p = jnp.exp(s - m)
    den = jnp.sum(p, axis=-1, keepdims=True)
    o = jnp.einsum('bhrnqk,bhrnkd->bhrnqd', p, vb.astype(F32)) / den
    lse = (m + jnp.log(den))[..., 0]
    o = o.reshape(bsz, H, dilation, npad, hd)[:, :, :, :n].transpose(0, 1, 3, 2, 4).reshape(bsz, H, L, hd)
    lse = lse.reshape(bsz, H, dilation, npad)[:, :, :, :n].transpose(0, 1, 3, 2).reshape(bsz, H, L)
    return o, lse


def dilated_attention(q, k, v, pos, g_q, g_k):
    bsz, L, _ = q.shape

    def heads(t):
        return t.reshape(bsz, L, ATT_HEADS, ATT_HEAD_DIM).transpose(0, 2, 1, 3)

    qh = rope(rmsnorm(heads(q), g_q), pos)
    kh = rope(rmsnorm(heads(k), g_k), pos)
    vh = heads(v)
    outs, lses = [], []
    for gi, (window, dil) in enumerate(DIL_PAIRS):
        sl = slice(gi * ATT_SLOTS, (gi + 1) * ATT_SLOTS)
        o, lse = dilated_group(qh[:, sl], kh[:, sl], vh[:, sl], dil, window // dil)
        outs.append(o)
        lses.append(lse)
    alpha = jax.nn.softmax(jnp.stack(lses), axis=0)
    out = jnp.sum(alpha[..., None] * jnp.stack(outs), axis=0)
    return out.transpose(0, 2, 1, 3).reshape(bsz, L, ATT_OUT).astype(q.dtype)


def memory_attention(q, mem_n, w_kv, g_q, g_k):
    bsz, L, _ = q.shape
    M = mem_n.shape[1]
    kv = mem_n @ w_kv
    k = kv[..., :X_WIDTH].reshape(bsz, M, X_HEADS, X_HEAD_DIM).transpose(0, 2, 1, 3)
    v = kv[..., X_WIDTH:].reshape(bsz, M, X_HEADS, X_HEAD_DIM).transpose(0, 2, 1, 3)
    qh = q.reshape(bsz, L, X_HEADS, X_HEAD_DIM).transpose(0, 2, 1, 3)
    qh = rmsnorm(qh, g_q)
    k = rmsnorm(k, g_k)
    s = jnp.einsum('bhld,bhmd->bhlm', qh, k).astype(F32) * (X_HEAD_DIM ** -0.5)
    p = jax.nn.softmax(s, axis=-1)
    o = jnp.einsum('bhlm,bhmd->bhld', p, v.astype(F32))
    return o.transpose(0, 2, 1, 3).reshape(bsz, L, X_WIDTH).astype(q.dtype)


def swiglu(h, w_gate, w_up, w_down):
    return (jax.nn.silu(h @ w_gate) * (h @ w_up)) @ w_down


def moe_swiglu(h, w_router, w_gate, w_up, w_down):
    bsz, L, D = h.shape
    t = h.reshape(bsz * L, D)
    logits = (t @ w_router).astype(F32)
    top_v, top_i = lax.top_k(logits, TOP_K)
    wts = jax.nn.softmax(top_v, axis=-1)
    gate = jnp.sum(jax.nn.one_hot(top_i, N_EXPERTS, dtype=F32) * wts[..., None], axis=1)
    out = jnp.zeros((bsz * L, D), F32)
    for e in range(N_EXPERTS):
        ye = swiglu(t, w_gate[e], w_up[e], w_down[e]).astype(F32)
        out = out + gate[:, e:e + 1] * ye
    return out.reshape(bsz, L, D).astype(h.dtype)


def setup_inputs(seed: int = 0) -> dict:
    key = jax.random.key(seed)
    ks = iter(jax.random.split(key, 48))

    def nrm(shape, scale):
        return jax.random.normal(next(ks), shape, F32) * scale

    def gain(shape):
        return 1.0 + 0.02 * jax.random.normal(next(ks), shape, F32)

    x = nrm((BATCH, SEQ, D_MODEL), 1.0)
    mem = nrm((BATCH, MEM_LEN, D_MODEL), 1.0)
    positions = jnp.arange(SEQ, dtype=jnp.int32)[None, :] + jax.random.randint(
        next(ks), (BATCH, 1), 0, MAX_POS_OFFSET, dtype=jnp.int32)
    norm_mix = gain((DEPTH, D_MODEL))
    w_in = nrm((DEPTH, D_MODEL, IN_COLS), D_MODEL ** -0.5)
    n_idx = jnp.arange(SSM_STATE, dtype=F32)
    ssm_a_re = -0.5 + 0.01 * jax.random.normal(next(ks), (DEPTH, SSM_GROUPS, SSM_STATE), F32)
    ssm_a_im = math.pi * n_idx + 0.01 * jax.random.normal(next(ks), (DEPTH, SSM_GROUPS, SSM_STATE), F32)
    ssm_log_dt = jax.random.uniform(next(ks), (DEPTH, SSM_GROUPS), F32,
                                    math.log(DT_MIN), math.log(DT_MAX))
    b_scale = (2 * SSM_GROUP) ** -0.5
    c_scale = (2 * SSM_STATE) ** -0.5
    ssm_b_re = nrm((DEPTH, SSM_GROUPS, SSM_STATE, SSM_GROUP), b_scale)
    ssm_b_im = nrm((DEPTH, SSM_GROUPS, SSM_STATE, SSM_GROUP), b_scale)
    ssm_c_re = nrm((DEPTH, SSM_GROUPS, SSM_GROUP, SSM_STATE), c_scale)
    ssm_c_im = nrm((DEPTH, SSM_GROUPS, SSM_GROUP, SSM_STATE), c_scale)
    ssm_d = nrm((DEPTH, SSM_WIDTH), 1.0)
    ssm_w_glu = nrm((DEPTH, SSM_WIDTH, 2 * SSM_WIDTH), SSM_WIDTH ** -0.5)
    w_ssm_out = nrm((DEPTH, SSM_WIDTH, D_MODEL), SSM_WIDTH ** -0.5)
    att_q_norm = gain((DEPTH, ATT_HEAD_DIM))
    att_k_norm = gain((DEPTH, ATT_HEAD_DIM))
    w_att_out = nrm((DEPTH, ATT_OUT, D_MODEL), ATT_OUT ** -0.5)
    norm_mem = gain((DEPTH, D_MODEL))
    w_mem_kv = nrm((DEPTH, D_MODEL, 2 * X_WIDTH), D_MODEL ** -0.5)
    mem_q_norm = gain((DEPTH, X_HEAD_DIM))
    mem_k_norm = gain((DEPTH, X_HEAD_DIM))
    w_mem_out = nrm((DEPTH, X_WIDTH, D_MODEL), X_WIDTH ** -0.5)
    w_o = nrm((DEPTH, D_MODEL, D_MODEL), D_MODEL ** -0.5)
    norm_ffn = gain((DEPTH, D_MODEL))
    ffn_w_gate = nrm((N_DENSE, D_MODEL, D_FF), D_MODEL ** -0.5)
    ffn_w_up = nrm((N_DENSE, D_MODEL, D_FF), D_MODEL ** -0.5)
    ffn_w_down = nrm((N_DENSE, D_FF, D_MODEL), D_FF ** -0.5)
    moe_w_router = nrm((N_MOE, D_MODEL, N_EXPERTS), D_MODEL ** -0.5)
    moe_w_gate = nrm((N_MOE, N_EXPERTS, D_MODEL, D_FF_EXPERT), D_MODEL ** -0.5)
    moe_w_up = nrm((N_MOE, N_EXPERTS, D_MODEL, D_FF_EXPERT), D_MODEL ** -0.5)
    moe_w_down = nrm((N_MOE, N_EXPERTS, D_FF_EXPERT, D_MODEL), D_FF_EXPERT ** -0.5)
    return {'x': x, 'mem': mem, 'positions': positions, 'norm_mix': norm_mix, 'w_in': w_in,
            'ssm_a_re': ssm_a_re, 'ssm_a_im': ssm_a_im, 'ssm_log_dt': ssm_log_dt,
            'ssm_b_re': ssm_b_re, 'ssm_b_im': ssm_b_im, 'ssm_c_re': ssm_c_re, 'ssm_c_im': ssm_c_im,
            'ssm_d': ssm_d, 'ssm_w_glu': ssm_w_glu, 'w_ssm_out': w_ssm_out,
            'att_q_norm': att_q_norm, 'att_k_norm': att_k_norm, 'w_att_out': w_att_out,
            'norm_mem': norm_mem, 'w_mem_kv': w_mem_kv, 'mem_q_norm': mem_q_norm,
            'mem_k_norm': mem_k_norm, 'w_mem_out': w_mem_out, 'w_o': w_o, 'norm_ffn': norm_ffn,
            'ffn_w_gate': ffn_w_gate, 'ffn_w_up': ffn_w_up, 'ffn_w_down': ffn_w_down,
            'moe_w_router': moe_w_router, 'moe_w_gate': moe_w_gate, 'moe_w_up': moe_w_up,
            'moe_w_down': moe_w_down}


def reference(x, mem, positions, norm_mix, w_in, ssm_a_re, ssm_a_im, ssm_log_dt,
              ssm_b_re, ssm_b_im, ssm_c_re, ssm_c_im, ssm_d, ssm_w_glu, w_ssm_out,
              att_q_norm, att_k_norm, w_att_out, norm_mem, w_mem_kv, mem_q_norm,
              mem_k_norm, w_mem_out, w_o, norm_ffn, ffn_w_gate, ffn_w_up, ffn_w_down,
              moe_w_router, moe_w_gate, moe_w_up, moe_w_down):
    bsz, L, D = x.shape
    c0 = SSM_WIDTH
    c1 = c0 + ATT_WIDTH
    c2 = c1 + ATT_WIDTH
    c3 = c2 + ATT_WIDTH
    c4 = c3 + X_WIDTH
    for i in range(DEPTH):
        h = rmsnorm(x, norm_mix[i])
        z = h @ w_in[i]
        y_ssm = ssm_branch(z[..., :c0], ssm_a_re[i], ssm_a_im[i], ssm_log_dt[i],
                           ssm_b_re[i], ssm_b_im[i], ssm_c_re[i], ssm_c_im[i],
                           ssm_d[i], ssm_w_glu[i]) @ w_ssm_out[i]
        y_att = dilated_attention(z[..., c0:c1], z[..., c1:c2], z[..., c2:c3], positions,
                                  att_q_norm[i], att_k_norm[i]) @ w_att_out[i]
        mem_n = rmsnorm(mem, norm_mem[i])
        y_mem = memory_attention(z[..., c3:c4], mem_n, w_mem_kv[i],
                                 mem_q_norm[i], mem_k_norm[i]) @ w_mem_out[i]
        g = jax.nn.sigmoid(z[..., c4:].astype(F32)).reshape(bsz, L, N_BRANCH, D)
        merged = (g[..., 0, :] * y_ssm + g[..., 1, :] * y_att + g[..., 2, :] * y_mem).astype(x.dtype)
        x = x + merged @ w_o[i]
        h2 = rmsnorm(x, norm_ffn[i])
        if i % 2 == 0:
            j = i // 2
            x = x + swiglu(h2, ffn_w_gate[j], ffn_w_up[j], ffn_w_down[j])
        else:
            j = i // 2
            x = x + moe_swiglu(h2, moe_w_router[j], moe_w_gate[j], moe_w_up[j], moe_w_down[j])
    return x
```

```cpp
#include <hip/hip_runtime.h>
#include <cstdio>
#include <cstdint>
#include <cmath>

#ifndef FAST_ATT
#define FAST_ATT 1
#endif
#ifndef FAST_MEM
#define FAST_MEM 1
#endif
#ifndef FAST_SSM
#define FAST_SSM 1
#endif
#ifndef FAST_FFN
#define FAST_FFN 1
#endif
#ifndef FAST_MOE
#define FAST_MOE 1
#endif
#ifndef PROBE_LO
#define PROBE_LO 0
#endif
#ifndef PROBE_HI
#define PROBE_HI 0
#endif
#ifndef PROBE_N
#define PROBE_N 1
#endif

namespace nv {
constexpr int SEQ = 4096, DM = 1024;
constexpr float EPS = 1e-6f;
__device__ __forceinline__ float wave_sum(float v) {
#pragma unroll
    for (int o = 1; o < 64; o <<= 1) v += __shfl_xor(v, o);
    return v;
}
__device__ __forceinline__ float wave_max(float v) {
#pragma unroll
    for (int o = 1; o < 64; o <<= 1) v = fmaxf(v, __shfl_xor(v, o));
    return v;
}
__device__ __forceinline__ float sigmoidf_(float x) { return 1.f / (1.f + __expf(-x)); }
__device__ __forceinline__ float gelu_tanh(float x) { const float u = 0.7978845608028654f * (x + 0.044715f * x * x * x); return 0.5f * x * (1.f + tanhf(u)); }

__global__ void __launch_bounds__(256) k_rmsnorm(const float* __restrict__ x, const float* __restrict__ g, float* __restrict__ y, int rows) {
    const int wave = (blockIdx.x * 256 + threadIdx.x) >> 6, lane = threadIdx.x & 63;
    if (wave >= rows) return;
    const float* xr = x + (size_t)wave * DM; float* yr = y + (size_t)wave * DM;
    float v[16]; float ss = 0.f;
#pragma unroll
    for (int j = 0; j < 16; ++j) { v[j] = xr[lane + 64 * j]; ss += v[j] * v[j]; }
    ss = wave_sum(ss);
    const float r = rsqrtf(ss * (1.f / DM) + EPS);
#pragma unroll
    for (int j = 0; j < 16; ++j) yr[lane + 64 * j] = v[j] * r * g[lane + 64 * j];
}
template <int MODE>
__global__ void __launch_bounds__(256) k_gemm(const float* __restrict__ A, int lda, const float* __restrict__ B, int ldb, float* C, int ldc, int K, const float* aux, int ldaux) {
    __shared__ float As[16][132];
    __shared__ float Bs[16][132];
    const int tid = threadIdx.x, tx = tid & 15, ty = tid >> 4;
    const int m0 = blockIdx.y * 128, n0 = blockIdx.x * 128;
    float acc[8][8];
#pragma unroll
    for (int i = 0; i < 8; ++i)
#pragma unroll
        for (int j = 0; j < 8; ++j) acc[i][j] = 0.f;
    for (int k0 = 0; k0 < K; k0 += 16) {
#pragma unroll
        for (int i = 0; i < 8; ++i) { const int e = tid + 256 * i, r = e >> 4, c = e & 15; As[c][r] = A[(size_t)(m0 + r) * lda + k0 + c]; }
#pragma unroll
        for (int i = 0; i < 8; ++i) { const int e = tid + 256 * i, r = e >> 7, c = e & 127; Bs[r][c] = B[(size_t)(k0 + r) * ldb + n0 + c]; }
        __syncthreads();
#pragma unroll
        for (int kk = 0; kk < 16; ++kk) {
            float a[8], b[8];
#pragma unroll
            for (int i = 0; i < 8; ++i) a[i] = As[kk][ty + 16 * i];
#pragma unroll
            for (int j = 0; j < 8; ++j) b[j] = Bs[kk][tx + 16 * j];
#pragma unroll
            for (int i = 0; i < 8; ++i)
#pragma unroll
                for (int j = 0; j < 8; ++j) acc[i][j] += a[i] * b[j];
        }
        __syncthreads();
    }
#pragma unroll
    for (int i = 0; i < 8; ++i)
#pragma unroll
        for (int j = 0; j < 8; ++j) {
            const int m = m0 + ty + 16 * i, n = n0 + tx + 16 * j; const size_t ci = (size_t)m * ldc + n; const float v = acc[i][j];
            if (MODE == 0) C[ci] = v;
            else if (MODE == 2) C[ci] = aux[(size_t)m * ldaux + n] + v;
            else if (MODE == 3) { const float gch = C[ci]; C[ci] = gch * sigmoidf_(gch) * v; }
            else if (MODE == 4) C[ci] = C[ci] + aux[(size_t)m * ldaux] * v;
        }
}
__global__ void __launch_bounds__(64) k_ssm(const float* __restrict__ U, float* __restrict__ Y, const float* a_re, const float* a_im, const float* log_dt, const float* b_re, const float* b_im,
                                            const float* c_re, const float* c_im, const float* dsk) {
    __shared__ float us[64][16];
    __shared__ float vs[16][65];
    __shared__ float ys[64][16];
    const int g = blockIdx.x, p = threadIdx.x;
    const float dt = expf(log_dt[g]);
    const float lr = a_re[g * 64 + p], li = a_im[g * 64 + p];
    const float mag = expf(lr * dt); float sn, cs; sincosf(li * dt, &sn, &cs);
    const float lbr = mag * cs, lbi = mag * sn;
    const float nr = lbr - 1.f, ni = lbi, den = lr * lr + li * li;
    const float fr = (nr * lr + ni * li) / den, fi = (ni * lr - nr * li) / den;
    float bbr[16], bbi[16], cr[16], ci[16];
#pragma unroll
    for (int c = 0; c < 16; ++c) {
        const float br = b_re[(g * 64 + p) * 16 + c], bi = b_im[(g * 64 + p) * 16 + c];
        bbr[c] = fr * br - fi * bi; bbi[c] = fr * bi + fi * br;
        cr[c] = c_re[(g * 16 + c) * 64 + p]; ci[c] = c_im[(g * 16 + c) * 64 + p];
    }
    const int cc = p & 15, qq = p >> 4;
    const float dskip = dsk[g * 16 + cc];
    float sr = 0.f, si = 0.f;
    for (int t0 = 0; t0 < SEQ; t0 += 64) {
        __syncthreads();
        { const float4* src = (const float4*)(U + (size_t)(t0 + p) * 512 + g * 16);
#pragma unroll
          for (int j = 0; j < 4; ++j) { const float4 v = src[j]; us[p][4 * j] = v.x; us[p][4 * j + 1] = v.y; us[p][4 * j + 2] = v.z; us[p][4 * j + 3] = v.w; } }
        __syncthreads();
        for (int t = 0; t < 64; ++t) {
            float bur = 0.f, bui = 0.f;
#pragma unroll
            for (int c = 0; c < 16; ++c) { const float u = us[t][c]; bur += bbr[c] * u; bui += bbi[c] * u; }
            const float nsr = lbr * sr - lbi * si + bur, nsi = lbr * si + lbi * sr + bui; sr = nsr; si = nsi;
#pragma unroll
            for (int c = 0; c < 16; ++c) vs[c][p] = cr[c] * sr - ci[c] * si;
            __syncthreads();
            float s = 0.f;
#pragma unroll
            for (int k = 0; k < 16; ++k) s += vs[cc][qq * 16 + k];
            s += __shfl_xor(s, 16); s += __shfl_xor(s, 32);
            if (qq == 0) ys[t][cc] = gelu_tanh(s + dskip * us[t][cc]);
            __syncthreads();
        }
        { float4* dst = (float4*)(Y + (size_t)(t0 + p) * 512 + g * 16);
#pragma unroll
          for (int j = 0; j < 4; ++j) dst[j] = make_float4(ys[p][4 * j], ys[p][4 * j + 1], ys[p][4 * j + 2], ys[p][4 * j + 3]); }
    }
}
__global__ void k_glu(const float* GA, float* S, int n) {
    const size_t i = (size_t)blockIdx.x * 256 + threadIdx.x; if (i >= (size_t)n) return;
    const size_t m = i >> 9; const int c = i & 511;
    S[i] = GA[m * 1024 + c] * sigmoidf_(GA[m * 1024 + 512 + c]);
}
template <int HD, bool ROPE>
__global__ void __launch_bounds__(256) k_headnorm(float* X, int ld, int col0, int nheads, int rows, const float* gain, const int* pos) {
    const int w = (blockIdx.x * 256 + threadIdx.x) >> 6, lane = threadIdx.x & 63;
    if (w >= rows * nheads) return;
    const int row = w / nheads, h = w % nheads;
    float* xp = X + (size_t)row * ld + col0 + h * HD;
    if (HD == 64) {
        const float x = xp[lane]; const float ss = wave_sum(x * x);
        float y = x * rsqrtf(ss * (1.f / 64) + EPS) * gain[lane];
        if (ROPE) {
            const float other = __shfl_xor(y, 32); const int j = lane & 31;
            const float inv = powf(10000.f, -(float)j / 32.f); const float ang = (float)pos[row] * inv;
            float sn, cs; sincosf(ang, &sn, &cs);
            y = (lane < 32) ? (y * cs - other * sn) : (other * sn + y * cs);
        }
        xp[lane] = y;
    } else {
        const float x0 = xp[lane], x1 = xp[lane + 64]; const float ss = wave_sum(x0 * x0 + x1 * x1);
        const float r = rsqrtf(ss * (1.f / 128) + EPS);
        xp[lane] = x0 * r * gain[lane]; xp[lane + 64] = x1 * r * gain[lane + 64];
    }
}
__global__ void __launch_bounds__(256) k_dilattn(const float* __restrict__ QKV, float* OG, float* LSE, int ntok) {
    const int w = (blockIdx.x * 256 + threadIdx.x) >> 6, lane = threadIdx.x & 63;
    if (w >= ntok * 12) return;
    const int h = w % 12, t = w / 12;
    const int g = h >> 2, slot = h & 3, d = (g == 0) ? 1 : (g == 1 ? 4 : 16);
    const int i = t / d, nk = (i < 128 ? i : 128) + 1;
    const float q = QKV[(size_t)t * 2304 + h * 64 + lane] * 0.125f;
    float s0 = -1e30f, s1 = -1e30f, s2 = -1e30f;
    for (int j = 0; j < nk; ++j) {
        const float k = QKV[(size_t)(t - j * d) * 2304 + 768 + h * 64 + lane];
        const float s = wave_sum(q * k);
        if (lane == (j & 63)) { if (j < 64) s0 = s; else if (j < 128) s1 = s; else s2 = s; }
    }
    const float m = wave_max(fmaxf(fmaxf(s0, s1), s2));
    const float p0 = (s0 > -1e29f) ? __expf(s0 - m) : 0.f, p1 = (s1 > -1e29f) ? __expf(s1 - m) : 0.f, p2 = (s2 > -1e29f) ? __expf(s2 - m) : 0.f;
    const float den = wave_sum(p0 + p1 + p2);
    float o = 0.f;
    for (int j = 0; j < nk; ++j) {
        const float pj = __shfl((j < 64) ? p0 : (j < 128 ? p1 : p2), j & 63);
        o += pj * QKV[(size_t)(t - j * d) * 2304 + 1536 + h * 64 + lane];
    }
    OG[((size_t)g * ntok + t) * 256 + slot * 64 + lane] = o / den;
    if (lane == 0) LSE[((size_t)g * ntok + t) * 4 + slot] = m + logf(den);
}
__global__ void k_attmerge(const float* OG, const float* LSE, float* AO, int ntok) {
    const size_t i = (size_t)blockIdx.x * 256 + threadIdx.x; if (i >= (size_t)ntok * 256) return;
    const size_t tok = i >> 8; const int c = i & 255, slot = c >> 6; const size_t N = ntok;
    const float l0 = LSE[(0 * N + tok) * 4 + slot], l1 = LSE[(1 * N + tok) * 4 + slot], l2 = LSE[(2 * N + tok) * 4 + slot];
    const float m = fmaxf(fmaxf(l0, l1), l2); const float e0 = __expf(l0 - m), e1 = __expf(l1 - m), e2 = __expf(l2 - m); const float inv = 1.f / (e0 + e1 + e2);
    AO[i] = (e0 * OG[(0 * N + tok) * 256 + c] + e1 * OG[(1 * N + tok) * 256 + c] + e2 * OG[(2 * N + tok) * 256 + c]) * inv;
}
__global__ void __launch_bounds__(256) k_memattn(const float* __restrict__ XQ, const float* __restrict__ KV, float* MO, int ntok) {
    const int w = (blockIdx.x * 256 + threadIdx.x) >> 6, lane = threadIdx.x & 63;
    if (w >= ntok * 4) return;
    const int h = w & 3, tok = w >> 2;
    const float sc = 0.08838834764831845f;
    const float q0 = XQ[(size_t)tok * 512 + h * 128 + lane] * sc, q1 = XQ[(size_t)tok * 512 + h * 128 + 64 + lane] * sc;
    float s[4] = {0.f, 0.f, 0.f, 0.f};
#pragma unroll
    for (int jj = 0; jj < 4; ++jj)
        for (int j = 0; j < 64; ++j) {
            const float* kr = KV + (size_t)(jj * 64 + j) * 1024 + h * 128;
            const float v = wave_sum(q0 * kr[lane] + q1 * kr[lane + 64]);
            if (lane == j) s[jj] = v;
        }
    const float m = wave_max(fmaxf(fmaxf(s[0], s[1]), fmaxf(s[2], s[3])));
    float p[4]; float ps = 0.f;
#pragma unroll
    for (int jj = 0; jj < 4; ++jj) { p[jj] = __expf(s[jj] - m); ps += p[jj]; }
    const float den = wave_sum(ps);
    float o0 = 0.f, o1 = 0.f;
#pragma unroll
    for (int jj = 0; jj < 4; ++jj)
        for (int j = 0; j < 64; ++j) {
            const float pj = __shfl(p[jj], j);
            const float* vr = KV + (size_t)(jj * 64 + j) * 1024 + 512 + h * 128;
            o0 += pj * vr[lane]; o1 += pj * vr[lane + 64];
        }
    MO[(size_t)tok * 512 + h * 128 + lane] = o0 / den; MO[(size_t)tok * 512 + h * 128 + 64 + lane] = o1 / den;
}
__global__ void __launch_bounds__(256) k_router(const float* __restrict__ H2, const float* __restrict__ Wr, float* gate, int rows) {
    const int w = (blockIdx.x * 256 + threadIdx.x) >> 6, lane = threadIdx.x & 63;
    if (w >= rows) return;
    float acc[8];
#pragma unroll
    for (int e = 0; e < 8; ++e) acc[e] = 0.f;
    for (int j = 0; j < 16; ++j) { const int k = lane + 64 * j; const float h = H2[(size_t)w * DM + k];
#pragma unroll
        for (int e = 0; e < 8; ++e) acc[e] += h * Wr[k * 8 + e]; }
#pragma unroll
    for (int e = 0; e < 8; ++e) acc[e] = wave_sum(acc[e]);
    int i0 = 0; float v0 = acc[0];
#pragma unroll
    for (int e = 1; e < 8; ++e) if (acc[e] > v0) { v0 = acc[e]; i0 = e; }
    int i1 = -1; float v1 = -3.4e38f;
#pragma unroll
    for (int e = 0; e < 8; ++e) if (e != i0 && acc[e] > v1) { v1 = acc[e]; i1 = e; }
    const float e1 = __expf(v1 - v0); const float w0 = 1.f / (1.f + e1), w1 = e1 / (1.f + e1);
    if (lane < 8) gate[(size_t)w * 8 + lane] = (lane == i0) ? w0 : ((lane == i1) ? w1 : 0.f);
}
__device__ __forceinline__ unsigned short f2bf_rne(float f) { unsigned u = __float_as_uint(f); return (unsigned short)((u + 0x7fffu + ((u >> 16) & 1u)) >> 16); }
__global__ void k_cvt_f2b(const float* src, unsigned short* dst, size_t n, int cols, int ldd) { const size_t i = (size_t)blockIdx.x * 256 + threadIdx.x; if (i < n) dst[(i / cols) * ldd + (i % cols)] = f2bf_rne(src[i]); }
}

namespace mk {
#define LAS __attribute__((address_space(3)))
#define GAS __attribute__((address_space(1)))
typedef unsigned short bf16_t;
typedef short bf16x8 __attribute__((ext_vector_type(8)));
typedef short s16x4 __attribute__((ext_vector_type(4)));
typedef float f32x4 __attribute__((ext_vector_type(4)));
typedef float f32x2 __attribute__((ext_vector_type(2)));
typedef unsigned u32x4 __attribute__((ext_vector_type(4)));
typedef unsigned u32x2 __attribute__((ext_vector_type(2)));
typedef __bf16 bf16x2_t __attribute__((ext_vector_type(2)));

constexpr int NB = 4, SEQ = 4096, DM = 1024, NT = NB * SEQ, INC = 6400;
constexpr int DFF = 2816, DFE = 3584, NE = 8;
constexpr float EPS = 1e-6f;
constexpr float LOG2E = 1.4426950408889634f, LN2 = 0.6931471805599453f;
constexpr int NWAVES = 8;

constexpr size_t MiB = (size_t)1 << 20;
constexpr size_t WS_CTL = 0, CTL_BYTES = 1 * MiB;
constexpr size_t WS_META = 1 * MiB;
constexpr size_t WS_ROPE = 2 * MiB;
constexpr size_t WS_SSMT = 6 * MiB;
constexpr size_t WS_WINP = 14 * MiB;
constexpr size_t WS_WL = 46 * MiB;
constexpr size_t WL_IN = 0, WL_GLU = 13 * MiB, WL_CAT = 14 * MiB  , WL_MKV = 17 * MiB, WL_WO = 19 * MiB;
constexpr size_t WL_STRIDE = 21 * MiB;
constexpr size_t WS_FFN = WS_WL + 2 * WL_STRIDE;
constexpr size_t WS_FFND = WS_FFN + 11 * MiB;
constexpr size_t WS_MEMN = 105 * MiB;
constexpr size_t WS_KVM = 109 * MiB;
constexpr size_t WS_SSMW = 113 * MiB;
constexpr size_t WS_A = 185 * MiB;
constexpr size_t WS_B = 217 * MiB;
constexpr size_t WS_C = 289 * MiB;
constexpr size_t WS_D = 305 * MiB;
constexpr size_t WS_E = 133 * MiB;
constexpr size_t WS_F = 419 * MiB;
constexpr size_t WS_CAT = 444 * MiB;
constexpr size_t WS_SSQ = 484 * MiB;
constexpr size_t WS_XS = 485 * MiB;
constexpr size_t WS_NAIVE = WS_B;
constexpr size_t WS_END = 518 * MiB;
constexpr size_t WS_MOEW = 2 * MiB;
constexpr size_t WS_MOEWD = WS_MOEW + 112 * MiB;
constexpr size_t WS_MOEH = 170 * MiB;
constexpr size_t WS_MOEA = 408 * MiB;
static_assert(WL_WO + 2 * MiB <= WL_STRIDE && WS_FFND + 6 * MiB <= WS_MEMN && WS_MOEA + 68 * MiB <= WS_END && WS_MOEH + 238 * MiB <= WS_MOEA, "ws map");
constexpr size_t MT_NT = 0;
constexpr size_t MT_TEXP = 1024;
constexpr size_t MT_TOKE = 4096;
constexpr size_t MT_TOKW = MT_TOKE + 65536;
constexpr size_t MT_POS = MT_TOKW + 131072;
constexpr size_t MT_ROWW = MT_POS + 131072;
constexpr size_t MT_RSA = MT_ROWW + 34816 * 4;
constexpr size_t MT_SEXP = 2048;
constexpr size_t MT_SINV = 2048 + 128;
static_assert(MT_RSA + 34816 * 4 <= MiB, "meta");

constexpr int RING_BYTES = 131072, LDSCTL_OFF = RING_BYTES, LDS_BYTES = 147456;

__device__ __forceinline__ unsigned pk2(float lo, float hi) { f32x2 v = {lo, hi}; bf16x2_t b = __builtin_convertvector(v, bf16x2_t); return __builtin_bit_cast(unsigned, b); }
__device__ __forceinline__ float bflo(unsigned w) { return __uint_as_float(w << 16); }
__device__ __forceinline__ float bfhi(unsigned w) { return __uint_as_float(w & 0xffff0000u); }
__device__ __forceinline__ float fsigmoid(float x) { return __builtin_amdgcn_rcpf(1.f + __builtin_amdgcn_exp2f(-x * LOG2E)); }
__device__ __forceinline__ float fgelu(float x) { return x * fsigmoid(1.5957691216057308f * (x + 0.044715f * x * x * x)); }
__device__ __forceinline__ int lane_id_l() { int l = (int)__builtin_amdgcn_mbcnt_hi(~0u, __builtin_amdgcn_mbcnt_lo(~0u, 0u)); asm volatile("" : "+v"(l)); return l; }
__device__ __forceinline__ float shx(float v, int m, int lane) { return __int_as_float(__builtin_amdgcn_ds_bpermute((lane ^ m) << 2, __float_as_int(v))); }
__device__ __forceinline__ float shi(float v, int src, int) { return __int_as_float(__builtin_amdgcn_ds_bpermute(src << 2, __float_as_int(v))); }
__device__ __forceinline__ float wave_sum(float v, int lane) {
#pragma unroll
    for (int o = 1; o < 64; o <<= 1) v += shx(v, o, lane);
    return v;
}
#define INF(k) lds_ptr<const float>(lds, (k))
#define LDS_WAIT() asm volatile("s_waitcnt lgkmcnt(0)" ::: "memory")
#define VM_WAIT() asm volatile("s_waitcnt vmcnt(0)" ::: "memory")

constexpr int BM = 256, BK = 64, HALF = 128, HTB = HALF * BK * 2, NXCD = 8, WGM = 8;
__device__ __forceinline__ int lds_byte(int r, int c) { const int st = (r >> 4) * 2 + (c >> 5), rr = r & 15, cc = c & 31, ob = rr * 64 + cc * 2; return st * 1024 + (ob ^ (((ob >> 9) & 1) << 5)); }
__device__ __forceinline__ void stage_rc(int b, int& R, int& C) { const int st = b / 1024, sb = b % 1024, swz = sb ^ (((sb >> 9) & 1) << 5); R = (st >> 1) * 16 + swz / 64; C = (st & 1) * 32 + (swz % 64) / 2; }
__device__ __forceinline__ int perm32(int rho) { const int n = rho >> 4, i = rho & 15; return 8 * (i >> 2) + 4 * n + (i & 3); }

__device__ __forceinline__ int lds_byte_b(int r, int bc) { const int st = (r >> 4) * 2 + (bc >> 6), rr = r & 15, ob = rr * 64 + (bc & 63); return st * 1024 + (ob ^ (((ob >> 9) & 1) << 5)); }
typedef int v8i32 __attribute__((ext_vector_type(8)));
__device__ __forceinline__ unsigned pk4_fp8(float a, float b, float c, float d) { int w = 0; w = __builtin_amdgcn_cvt_pk_fp8_f32(a, b, w, false); w = __builtin_amdgcn_cvt_pk_fp8_f32(c, d, w, true); return (unsigned)w; }
__device__ __forceinline__ float clamp448(float x) { return fminf(fmaxf(x, -448.f), 448.f); }
constexpr int LDSPTR_OFF = LDSCTL_OFF + 512;
template <typename T> __device__ __forceinline__ T* lds_ptr(LAS unsigned char* lds, int k) {
    unsigned off = LDSPTR_OFF + 8 * k; asm volatile("" : "+v"(off));
    const unsigned lo = *(volatile LAS unsigned*)(lds + off), hi = *(volatile LAS unsigned*)(lds + off + 4);
    typedef __attribute__((address_space(1))) T GT;
    return (T*)(GT*)(((unsigned long long)(unsigned)__builtin_amdgcn_readfirstlane((int)hi) << 32) | (unsigned long long)(unsigned)__builtin_amdgcn_readfirstlane((int)lo));
}
struct Unit { int pm, pn, pb, k0, nt, q; };
struct Gemm { const bf16_t* A; const bf16_t* Bt; int lda, ldb, K; };
struct Sched {
    int mode, nM, nN, nwg, G, c, pn0, nfull; const int* texp;
    __device__ __forceinline__ bool next(int i, Unit& u) const {
        const long L = (long)i * G + c; if (L >= nwg) return false;
        u.k0 = 0; u.nt = 0; u.q = 0;
        if (mode == 1) { u.pm = (int)L / nN; u.pn = (int)L % nN; u.pb = u.pm * nN + u.pn; return true; }
        if (mode == 5) { u.pm = (int)L / nN; u.pn = (int)L % nN; u.pb = (u.pm >> 1) * nN + u.pn; return true; }
        if (mode == 4 && L >= (long)nfull * nN) { const int j = (int)L - nfull * nN; u.pm = nfull + (j >> 4); u.pn = (j >> 2) & 3; u.q = j & 3; u.k0 = (u.q < 2) ? 1024 * u.q : 2048 + 768 * (u.q - 2); u.nt = (u.q < 2) ? 8 : 6;
            u.pb = __builtin_amdgcn_readfirstlane(__hip_atomic_load(texp + u.pm, __ATOMIC_RELAXED, __HIP_MEMORY_SCOPE_AGENT)) * nN + u.pn; return true; }
        if (mode == 3) { u.pm = (int)L / nN; u.pn = (int)L % nN; u.pb = (u.pm >> 2) * (int)(WL_STRIDE / (512 * 1024)) + u.pn; return true; }
        const int nwg_ = (mode == 4) ? nfull * nN : nwg;
        int wgid = (int)L; { const int q = nwg_ / NXCD, r = nwg_ % NXCD, xcd = wgid % NXCD, off = wgid / NXCD; wgid = (xcd < r ? xcd * (q + 1) : r * (q + 1) + (xcd - r) * q) + off; }
        const int nM_ = (mode == 4) ? nfull : nM;
        const int nig = WGM * nN, gid = wgid / nig, fm = gid * WGM, gsz = (nM_ - fm) < WGM ? (nM_ - fm) : WGM;
        u.pm = fm + ((wgid % nig) % gsz); u.pn = (wgid % nig) / gsz + pn0; u.pb = u.pn;
        if (mode == 2 || mode == 4) u.pb = __builtin_amdgcn_readfirstlane(__hip_atomic_load(texp + u.pm, __ATOMIC_RELAXED, __HIP_MEMORY_SCOPE_AGENT)) * nN + u.pn;
        return true;
    }
};
enum { EP_INPROJ = 0, EP_BF16, EP_GLU, EP_SWIGLU, EP_SWIGLUQ, EP_MERGEF, EP_RESID, EP_SSMOUT, EP_ZSCAN, EP_MOEDOWN, EP_MOEDOWNQ, EP_GATEQ };
struct Epi {
    int mode, perm, after_drain;
    bf16_t* o0; bf16_t* o1; bf16_t* o2; bf16_t* o3; int ldo;
    const bf16_t* gt;
    float* fo; const float* fr;
    const float* ptab;
    unsigned char* x8;
    bf16_t* xb; float* ssq; const float* ssqr;

    __device__ __forceinline__ void run_qk(const f32x4 (&acc)[2][2][4][2], const Unit& u, int wr, int wc, int fr_, int fq, LAS unsigned char* lds) const {
        const int row0 = u.pm * BM + wr * 64 + fr_, lane_ = fq * 16 + fr_;
        const bool isq = u.pn < 5;
        const int lay = __builtin_amdgcn_readfirstlane(*(volatile LAS int*)(lds + LDSCTL_OFF + 256 + 4 * (wr * 4 + wc)));
        const float* gp = lds_ptr<const float>(lds, isq ? 15 : 16) + lay * 64 + 8 * fq;
        const float* rope = (const float*)(lds_ptr<const unsigned char>(lds, 33) + WS_ROPE);
        const f32x4 g00 = *(const f32x4*)gp, g01 = *(const f32x4*)(gp + 4), g10 = *(const f32x4*)(gp + 32), g11 = *(const f32x4*)(gp + 36);
        const float qs = isq ? 0.125f * LOG2E : 1.0f;
#pragma unroll
        for (int ai = 0; ai < 2; ++ai)
#pragma unroll
            for (int m = 0; m < 4; ++m) { const int row = row0 + ai * HALF + m * 16; float rstd = 1.f;
                if (ssqr) { const f32x4 p4 = *(const f32x4*)(ssqr + (size_t)row * 16 + 4 * fq); float sq = (p4.x + p4.y) + (p4.z + p4.w); sq += shx(sq, 16, lane_); sq += shx(sq, 32, lane_); rstd = 1.0f / sqrtf(sq * (1.f / DM) + EPS); }
                f32x4 a0 = acc[ai][0][m][0] * rstd, a1 = acc[ai][0][m][1] * rstd, b0 = acc[ai][1][m][0] * rstd, b1 = acc[ai][1][m][1] * rstd;
                float ss = (a0.x * a0.x + a0.y * a0.y) + (a0.z * a0.z + a0.w * a0.w) + (a1.x * a1.x + a1.y * a1.y) + (a1.z * a1.z + a1.w * a1.w)
                         + (b0.x * b0.x + b0.y * b0.y) + (b0.z * b0.z + b0.w * b0.w) + (b1.x * b1.x + b1.y * b1.y) + (b1.z * b1.z + b1.w * b1.w);
                ss += shx(ss, 16, lane_); ss += shx(ss, 32, lane_);
                const float r = qs / sqrtf(ss * (1.f / 64.f) + EPS);
                a0 = a0 * r * g00; a1 = a1 * r * g01; b0 = b0 * r * g10; b1 = b1 * r * g11;
                const f32x4* rp = (const f32x4*)(rope + (size_t)row * 64 + 16 * fq);
                const f32x4 t0 = rp[0], t1 = rp[1], t2 = rp[2], t3 = rp[3];
                f32x4 o00, o01, o10, o11;
                o00.x = a0.x * t0.x - b0.x * t0.y; o10.x = a0.x * t0.y + b0.x * t0.x; o00.y = a0.y * t0.z - b0.y * t0.w; o10.y = a0.y * t0.w + b0.y * t0.z;
                o00.z = a0.z * t1.x - b0.z * t1.y; o10.z = a0.z * t1.y + b0.z * t1.x; o00.w = a0.w * t1.z - b0.w * t1.w; o10.w = a0.w * t1.w + b0.w * t1.z;
                o01.x = a1.x * t2.x - b1.x * t2.y; o11.x = a1.x * t2.y + b1.x * t2.x; o01.y = a1.y * t2.z - b1.y * t2.w; o11.y = a1.y * t2.w + b1.y * t2.z;
                o01.z = a1.z * t3.x - b1.z * t3.y; o11.z = a1.z * t3.y + b1.z * t3.x; o01.w = a1.w * t3.z - b1.w * t3.w; o11.w = a1.w * t3.w + b1.w * t3.z;
                bf16_t* dst = o1 + (size_t)row * 2304 + (u.pn * BM - 512) + 64 * wc + 8 * fq;
                u32x4 w; w.x = pk2(o00.x, o00.y); w.y = pk2(o00.z, o00.w); w.z = pk2(o01.x, o01.y); w.w = pk2(o01.z, o01.w); *(u32x4*)dst = w;
                w.x = pk2(o10.x, o10.y); w.y = pk2(o10.z, o10.w); w.z = pk2(o11.x, o11.y); w.w = pk2(o11.z, o11.w); *(u32x4*)(dst + 32) = w; }
    }
    template <bool FP8> __device__ __forceinline__ void run(const f32x4 (&acc)[2][2][4][2], const Unit& u, int wr, int wc, int fr_, int fq, LAS unsigned char* lds) const {
        if (!FP8 && mode == EP_INPROJ && u.pn >= 2 && u.pn < 8) { run_qk(acc, u, wr, wc, fr_, fq, lds); return; }
        const int row0 = u.pm * BM + wr * 64 + fr_;
        const unsigned char* wsm = lds_ptr<const unsigned char>(lds, 33) + WS_META;
        const float* roww = (const float*)(wsm + MT_ROWW); const float* rsa = (const float*)(wsm + MT_RSA); const float* sinv = (const float*)(wsm + MT_SINV); const int* sexp = (const int*)(wsm + MT_SEXP);
        if (!FP8 && mode == EP_RESID) {
            const int lane_ = fq * 16 + fr_;
#pragma unroll
            for (int ai = 0; ai < 2; ++ai)
#pragma unroll
                for (int m = 0; m < 4; ++m) { const int row = row0 + ai * HALF + m * 16; float ss = 0.f;
#pragma unroll
                    for (int bj = 0; bj < 2; ++bj) { const size_t off = (size_t)row * DM + u.pn * BM + bj * HALF + wc * 32 + 8 * fq;
                        f32x4 x0, x1;
                        if (fr) { x0 = *(const f32x4*)(fr + off); x1 = *(const f32x4*)(fr + off + 4); }
                        else { const u32x4 rv = *(const u32x4*)(xb + off); x0 = (f32x4){bflo(rv.x), bfhi(rv.x), bflo(rv.y), bfhi(rv.y)}; x1 = (f32x4){bflo(rv.z), bfhi(rv.z), bflo(rv.w), bfhi(rv.w)}; }
                        x0 = x0 + acc[ai][bj][m][0]; x1 = x1 + acc[ai][bj][m][1];
                        u32x4 w; w.x = pk2(x0.x, x0.y); w.y = pk2(x0.z, x0.w); w.z = pk2(x1.x, x1.y); w.w = pk2(x1.z, x1.w); *(u32x4*)(xb + off) = w;
                        if (x8) { u32x2 q; q.x = pk4_fp8(clamp448(16.f * x0.x), clamp448(16.f * x0.y), clamp448(16.f * x0.z), clamp448(16.f * x0.w)); q.y = pk4_fp8(clamp448(16.f * x1.x), clamp448(16.f * x1.y), clamp448(16.f * x1.z), clamp448(16.f * x1.w)); *(u32x2*)(x8 + off) = q; }
                        ss += (x0.x * x0.x + x0.y * x0.y) + (x0.z * x0.z + x0.w * x0.w) + (x1.x * x1.x + x1.y * x1.y) + (x1.z * x1.z + x1.w * x1.w); }
                    ss += shx(ss, 16, lane_); ss += shx(ss, 32, lane_); if (fq == 0) ssq[(size_t)row * 16 + u.pn * 4 + wc] = ss; }
            return;
        }
        if (FP8 && mode == EP_GATEQ) {
            const int lay = __builtin_amdgcn_readfirstlane(*(volatile LAS int*)(lds + LDSCTL_OFF + 256 + 4 * (wr * 4 + wc)));
            const float sc = sinv[27 + lay] * 0.0625f; const int lane_ = fq * 16 + fr_;
#pragma unroll
            for (int ai = 0; ai < 2; ++ai)
#pragma unroll
                for (int m = 0; m < 4; ++m) { const int row = row0 + ai * HALF + m * 16; float rs = sc;
                    if (ssqr) { const f32x4 p4 = *(const f32x4*)(ssqr + (size_t)row * 16 + 4 * fq); float sq = (p4.x + p4.y) + (p4.z + p4.w); sq += shx(sq, 16, lane_); sq += shx(sq, 32, lane_); rs *= 1.0f / sqrtf(sq * (1.f / DM) + EPS); }
#pragma unroll
                    for (int bj = 0; bj < 2; ++bj) { const int col = u.pn * BM + bj * HALF + wc * 32 + 8 * fq; float v[8];
#pragma unroll
                        for (int e = 0; e < 4; ++e) { v[e] = acc[ai][bj][m][0][e] * rs; v[4 + e] = acc[ai][bj][m][1][e] * rs; }
#pragma unroll
                        for (int e = 0; e < 8; ++e) v[e] = fminf(1.f + __builtin_amdgcn_exp2f(-v[e] * LOG2E), 1048576.f);
                        u32x4 w; w.x = pk2(v[0], v[1]); w.y = pk2(v[2], v[3]); w.z = pk2(v[4], v[5]); w.w = pk2(v[6], v[7]); *(u32x4*)(o3 + (size_t)row * 3072 + col) = w; } }
            return;
        }
        if (FP8 && mode == EP_MOEDOWNQ) {
            const int ex = u.pb >> 2; const float sc = sinv[16 + ex] * __builtin_amdgcn_exp2f((float)(13 - sexp[2 * ex] - sexp[2 * ex + 1]));
#pragma unroll
            for (int ai = 0; ai < 2; ++ai)
#pragma unroll
                for (int m = 0; m < 4; ++m) { const int row = row0 + ai * HALF + m * 16; const float w = roww[row] * sc;
#pragma unroll
                    for (int bj = 0; bj < 2; ++bj) { const int col = u.pn * BM + bj * HALF + wc * 32 + 8 * fq; u32x4 o;
                        o.x = pk2(acc[ai][bj][m][0][0] * w, acc[ai][bj][m][0][1] * w); o.y = pk2(acc[ai][bj][m][0][2] * w, acc[ai][bj][m][0][3] * w);
                        o.z = pk2(acc[ai][bj][m][1][0] * w, acc[ai][bj][m][1][1] * w); o.w = pk2(acc[ai][bj][m][1][2] * w, acc[ai][bj][m][1][3] * w);
                        bf16_t* dp = (u.q == 0) ? o0 + (size_t)row * DM + col : o1 + ((size_t)(u.q - 1) * 2048 + (row - 32768)) * DM + col;
                        *(u32x4*)dp = o; } }
            return;
        }
        if (FP8 || mode == EP_GLU || mode == EP_SWIGLU) {
            const int col0 = u.pn * HALF + wc * 32 + 8 * fq;
            float sg = 1.f, su = 1.f, hs = 1.f; if (FP8) { const int ex = u.pb / 28; sg = sinv[2 * ex]; su = sinv[2 * ex + 1]; hs = __builtin_amdgcn_exp2f((float)(sexp[2 * ex] + sexp[2 * ex + 1] - 13)); }
#pragma unroll
            for (int ai = 0; ai < 2; ++ai)
#pragma unroll
                for (int m = 0; m < 4; ++m) { const int row = row0 + ai * HALF + m * 16; float v[8]; float ra = sg, rb = su; if (FP8) { const float rs = rsa[row]; ra *= rs; rb *= rs; }
                    if (!FP8 && ssqr) { const int lane_ = fq * 16 + fr_; const f32x4 p4 = *(const f32x4*)(ssqr + (size_t)row * 16 + 4 * fq); float sq = (p4.x + p4.y) + (p4.z + p4.w); sq += shx(sq, 16, lane_); sq += shx(sq, 32, lane_); ra = rb = 1.0f / sqrtf(sq * (1.f / DM) + EPS); }
                    const float kk = ra * rb * (FP8 ? hs : 1.f), rneg = -LOG2E * ra;
#pragma unroll
                    for (int n = 0; n < 2; ++n)
#pragma unroll
                        for (int e = 0; e < 4; ++e) {
                            if (mode == EP_GLU) { const float a = acc[ai][0][m][n][e] * ra, b = acc[ai][1][m][n][e] * rb; v[4 * n + e] = a * fsigmoid(b); }
                            else {
                                const float ag = acc[ai][0][m][n][e], au = acc[ai][1][m][n][e];
                                v[4 * n + e] = (ag * au) * (kk * __builtin_amdgcn_rcpf(1.f + __builtin_amdgcn_exp2f(ag * rneg))); } }
                    if (FP8) {
#pragma unroll
                        for (int e = 0; e < 8; ++e) v[e] = __builtin_amdgcn_fmed3f(v[e], -448.f, 448.f);
                        u32x2 w; w.x = pk4_fp8(v[0], v[1], v[2], v[3]); w.y = pk4_fp8(v[4], v[5], v[6], v[7]); *(u32x2*)((unsigned char*)o0 + (size_t)row * ldo + col0) = w;
                    } else { u32x4 w; w.x = pk2(v[0], v[1]); w.y = pk2(v[2], v[3]); w.z = pk2(v[4], v[5]); w.w = pk2(v[6], v[7]); *(u32x4*)(o0 + (size_t)row * ldo + col0) = w; } }
            return;
        }
        if constexpr (!FP8)
#pragma unroll
        for (int ai = 0; ai < 2; ++ai)
#pragma unroll
            for (int m = 0; m < 4; ++m) { const int row = row0 + ai * HALF + m * 16; float rstd = 1.f;
                if (mode == EP_INPROJ && ssqr) { const int lane_ = fq * 16 + fr_; const f32x4 p4 = *(const f32x4*)(ssqr + (size_t)row * 16 + 4 * fq); float sq = (p4.x + p4.y) + (p4.z + p4.w); sq += shx(sq, 16, lane_); sq += shx(sq, 32, lane_); rstd = 1.0f / sqrtf(sq * (1.f / DM) + EPS); }
#pragma unroll
                for (int bj = 0; bj < 2; ++bj) {
                    const int col = u.pn * BM + bj * HALF + wc * 32 + 8 * fq;
                    float v[8];
#pragma unroll
                    for (int e = 0; e < 4; ++e) { v[e] = acc[ai][bj][m][0][e]; v[4 + e] = acc[ai][bj][m][1][e]; }
                    bf16_t* dst;
                    if (mode == EP_INPROJ) {
#pragma unroll
                        for (int e = 0; e < 8; ++e) v[e] *= rstd;
                        if (col < 512) { const int g = col >> 4, cp = col & 15, b = row >> 12, t = row & 4095, k = t >> 5, s = t & 31; dst = o0 + ((size_t)(g * 512 + b * 128 + k)) * 640 + s * 16 + cp; }
                        else if (col < 2816) dst = o1 + (size_t)row * 2304 + (col - 512);
                        else if (col < 3328) dst = o2 + (size_t)row * 512 + (col - 2816);
                        else { dst = o3 + (size_t)row * 3072 + (col - 3328);
#pragma unroll
                            for (int e = 0; e < 8; ++e) v[e] = fminf(1.f + __builtin_amdgcn_exp2f(-v[e] * LOG2E), 1048576.f); }
                    } else if (mode == EP_BF16) { dst = o0 + (size_t)row * ldo + col;
                    } else if (mode == EP_MERGEF) {
                        dst = o0 + (size_t)row * DM + col;
                        const u32x4 gv = *(const u32x4*)(gt + 2048 + (size_t)row * 3072 + col);
                        const float gg[8] = {bflo(gv.x), bfhi(gv.x), bflo(gv.y), bfhi(gv.y), bflo(gv.z), bfhi(gv.z), bflo(gv.w), bfhi(gv.w)};
#pragma unroll
                        for (int e = 0; e < 8; ++e) v[e] *= __builtin_amdgcn_rcpf(gg[e]);
                    } else if (mode == EP_SSMOUT) {
                        const int g = u.pm >> 1, rg = row & 511, b = rg >> 7, k = rg & 127, t = col >> 4, c = col & 15;
                        dst = o0 + ((size_t)(b * 4096 + k * 32 + t)) * 512 + g * 16 + c;
#pragma unroll
                        for (int e = 0; e < 8; ++e) v[e] = fgelu(v[e]);
                    } else {
                        dst = o0 + (size_t)row * DM + col; const float w = roww[row];
#pragma unroll
                        for (int e = 0; e < 8; ++e) v[e] *= w;
                    }
                    u32x4 w; w.x = pk2(v[0], v[1]); w.y = pk2(v[2], v[3]); w.z = pk2(v[4], v[5]); w.w = pk2(v[6], v[7]); *(u32x4*)dst = w;
                } }
    }
    __device__ __forceinline__ void fused(const f32x4 (&acc)[2][2][4][2], const Unit& u, int wr, int wc, int fr_, int fq, LAS unsigned char* lds, int tid) const {
        LAS float* Zs = (LAS float*)lds;
#pragma unroll
        for (int ai = 0; ai < 2; ++ai)
#pragma unroll
            for (int m = 0; m < 4; ++m)
#pragma unroll
                for (int n = 0; n < 2; ++n) { const int row = ai * HALF + wr * 64 + m * 16 + fr_, col = wc * 32 + n * 16 + 4 * fq; *(LAS f32x4*)(Zs + row * 128 + col) = acc[ai][0][m][n]; }
        LDS_WAIT(); __builtin_amdgcn_s_barrier(); asm volatile("" ::: "memory");
        if (tid < 128) {
            const int bb = tid >> 6, p = tid & 63, g = u.pm >> 1;
            const f32x2 lt = *(const f32x2*)(ptab + ((size_t)(g * 33 + 32) * 64 + p) * 2);
            float sr = 0.f, si = 0.f;
            bf16_t* dst = o0 + ((size_t)(u.pm * 256 + bb * 128)) * 640 + 512 + 2 * p;
            for (int k = 0; k < 128; ++k) {
                *(unsigned*)(dst + (size_t)k * 640) = pk2(sr, si);
                const float zr = Zs[(bb * 128 + k) * 128 + 2 * p], zi = Zs[(bb * 128 + k) * 128 + 2 * p + 1];
                const float nr = lt.x * sr - lt.y * si + zr, ni = lt.x * si + lt.y * sr + zi; sr = nr; si = ni;
            }
        }
        LDS_WAIT(); __builtin_amdgcn_s_barrier(); asm volatile("" ::: "memory");
    }
};

template <bool FP8>
__device__ __forceinline__ void gemm_phase(LAS unsigned char* lds, const int wid, const Gemm g, const Sched& S, const Epi& E) {
    constexpr int ESZ = FP8 ? 1 : 2, BKE = FP8 ? 128 : 64;
    const int lane = lane_id_l(), tid = wid * 64 + lane, wr = wid >> 2, wc = wid & 3, fr = lane & 15, fq = lane >> 4;
    const int K = g.K, nt = K / BKE;
    unsigned voffA, voffB;
    { int R, C; stage_rc(tid * 16, R, C); const int Rb = E.perm ? ((R & ~31) + perm32(R & 31)) : R;
        voffA = (unsigned)(R * g.lda * ESZ + C * 2); voffB = (unsigned)(Rb * g.ldb * ESZ + C * 2); }
    const size_t p2A = (size_t)64 * g.lda * ESZ, p2B = (size_t)64 * g.ldb * ESZ;
    const size_t kstep = (size_t)(BK * 2);
    const size_t hstepA = (size_t)HALF * g.lda * ESZ, hstepB = (size_t)HALF * g.ldb * ESZ, tstepA = 2 * hstepA, tstepB = 2 * hstepB;
    const unsigned ldsw = (unsigned)wid * 1024u;
    const int aoff = FP8 ? lds_byte_b(wr * 64 + fr, fq * 32) : lds_byte(wr * 64 + fr, fq * 8), boff = FP8 ? lds_byte_b(wc * 32 + fr, fq * 32) : lds_byte(wc * 32 + fr, fq * 8);
#define PG8_SA(b, h) (((b) * 2 + (h)) * HTB)
#define PG8_SB(b, h) ((4 + (b) * 2 + (h)) * HTB)
#define PG8_STAGE2(bufoff, gbase, voff, p2) do { const char* _g0 = (const char*)(gbase); const char* _g1 = _g0 + (p2); asm volatile("" : "+s"(_g0), "+s"(_g1));   \
        __builtin_amdgcn_global_load_lds((const unsigned*)(_g0 + (voff)), (LAS unsigned*)(lds + (bufoff) + ldsw), 16, 0, 0); \
        __builtin_amdgcn_global_load_lds((const unsigned*)(_g1 + (voff)), (LAS unsigned*)(lds + (bufoff) + ldsw + 8192), 16, 0, 0); } while (0)
#define PG8_STAGE(bufoff, gbase, voff) PG8_STAGE2(bufoff, gbase, voff, PG8_P2_##voff)
#define PG8_P2_voffA p2A
#define PG8_P2_voffB p2B
#define PG8_LDA(dst, b, h) do { if constexpr (FP8) { _Pragma("unroll") for (int m = 0; m < 4; ++m) dst##8[m] = *(const LAS v8i32*)(lds + PG8_SA(b, h) + aoff + m * 2048); } \
        else { _Pragma("unroll") for (int m = 0; m < 4; ++m) _Pragma("unroll") for (int k = 0; k < 2; ++k) dst[m][k] = *(const LAS bf16x8*)(lds + PG8_SA(b, h) + aoff + m * 2048 + k * 1024); } } while (0)
#define PG8_LDB(dst, b, h) do { if constexpr (FP8) { _Pragma("unroll") for (int n = 0; n < 2; ++n) dst##8[n] = *(const LAS v8i32*)(lds + PG8_SB(b, h) + boff + n * 2048); } \
        else { _Pragma("unroll") for (int n = 0; n < 2; ++n) _Pragma("unroll") for (int k = 0; k < 2; ++k) dst[n][k] = *(const LAS bf16x8*)(lds + PG8_SB(b, h) + boff + n * 2048 + k * 1024); } } while (0)
#define PG8_MMA(ai, bj, At, Bt) do { __builtin_amdgcn_s_setprio(1); _Pragma("unroll") for (int m = 0; m < 4; ++m) _Pragma("unroll") for (int n = 0; n < 2; ++n) { \
        if constexpr (FP8) acc[ai][bj][m][n] = __builtin_amdgcn_mfma_scale_f32_16x16x128_f8f6f4(Bt##8[n], At##8[m], acc[ai][bj][m][n], 0, 0, 0, 0, 0, 0); \
        else { _Pragma("unroll") for (int k = 0; k < 2; ++k) acc[ai][bj][m][n] = __builtin_amdgcn_mfma_f32_16x16x32_bf16(Bt[n][k], At[m][k], acc[ai][bj][m][n], 0, 0, 0); } } \
        __builtin_amdgcn_s_setprio(0); } while (0)
#define PG8_WAIT_V(n) asm volatile("s_waitcnt vmcnt(" #n ")" ::: "memory")
#define PG8_WAIT_L(n) asm volatile("s_waitcnt lgkmcnt(" #n ")" ::: "memory")
#define PG8_BAR __builtin_amdgcn_s_barrier()
#define PG8_SCHED __builtin_amdgcn_sched_barrier(0)
    Unit cur, nxt; int ui = 0;
    if (!S.next(0, cur)) return;
    f32x4 acc[2][2][4][2]; float zf = 0.f; asm volatile("" : "+v"(zf));
#pragma unroll
    for (int a = 0; a < 2; ++a)
#pragma unroll
        for (int b = 0; b < 2; ++b)
#pragma unroll
            for (int m = 0; m < 4; ++m)
#pragma unroll
                for (int n = 0; n < 2; ++n) acc[a][b][m][n] = (f32x4){zf, zf, zf, zf};
    bf16x8 At[4][2], B0[2][2], B1[2][2]; v8i32 At8[4], B08[2], B18[2];
    const char* cA = (const char*)g.A + (size_t)cur.pm * tstepA + (size_t)cur.k0 * ESZ; const char* cB = (const char*)g.Bt + (size_t)cur.pb * tstepB + (size_t)cur.k0 * ESZ;
    PG8_STAGE(PG8_SB(0, 0), cB, voffB); PG8_STAGE(PG8_SB(0, 1), cB + hstepB, voffB); PG8_STAGE(PG8_SA(0, 0), cA, voffA); PG8_STAGE(PG8_SA(0, 1), cA + hstepA, voffA);
    if (wr == 1) PG8_BAR;
    PG8_WAIT_V(2); PG8_BAR;
    PG8_STAGE(PG8_SB(1, 0), cB + kstep, voffB); PG8_STAGE(PG8_SA(1, 0), cA + kstep, voffA); PG8_STAGE(PG8_SB(1, 1), cB + hstepB + kstep, voffB);
    PG8_WAIT_V(6); PG8_BAR;
    for (;;) {
        const bool has_next = S.next(ui + 1, nxt);
        const char* nA = has_next ? (const char*)g.A + (size_t)nxt.pm * tstepA + (size_t)nxt.k0 * ESZ : cA; const char* nB = has_next ? (const char*)g.Bt + (size_t)nxt.pb * tstepB + (size_t)nxt.k0 * ESZ : cB;
        const int unt = cur.nt ? cur.nt : nt;
        for (int t = 0; t < unt; t += 2) {
            const bool last = (t == unt - 2);
            const char* a1 = cA + (size_t)(t + 1) * kstep;
            const char* a2 = last ? nA : cA + (size_t)(t + 2) * kstep; const char* b2 = last ? nB : cB + (size_t)(t + 2) * kstep;
            const char* a3 = a2 + kstep; const char* b3 = b2 + kstep;
            if constexpr (!FP8) if (E.mode == EP_MERGEF && (t == 8 || t == 12)) {
                const bf16_t* va = E.gt + (t == 8 ? 0 : 1024); const int tl = lane_id_l(); const int frl = tl & 15, fql = tl >> 4;
#pragma unroll
                for (int ai = 0; ai < 2; ++ai)
#pragma unroll
                    for (int m = 0; m < 4; ++m)
#pragma unroll
                        for (int bj = 0; bj < 2; ++bj) {
                            const size_t off = (size_t)(cur.pm * BM + ai * HALF + wr * 64 + m * 16 + frl) * 3072 + cur.pn * BM + bj * HALF + wc * 32 + 8 * fql;
                            const u32x4 av = *(const u32x4*)(va + off), bv = *(const u32x4*)(va + 1024 + off);
                            acc[ai][bj][m][0][0] *= bflo(bv.x) * __builtin_amdgcn_rcpf(bflo(av.x)); acc[ai][bj][m][0][1] *= bfhi(bv.x) * __builtin_amdgcn_rcpf(bfhi(av.x));
                            acc[ai][bj][m][0][2] *= bflo(bv.y) * __builtin_amdgcn_rcpf(bflo(av.y)); acc[ai][bj][m][0][3] *= bfhi(bv.y) * __builtin_amdgcn_rcpf(bfhi(av.y));
                            acc[ai][bj][m][1][0] *= bflo(bv.z) * __builtin_amdgcn_rcpf(bflo(av.z)); acc[ai][bj][m][1][1] *= bfhi(bv.z) * __builtin_amdgcn_rcpf(bfhi(av.z));
                            acc[ai][bj][m][1][2] *= bflo(bv.w) * __builtin_amdgcn_rcpf(bflo(av.w)); acc[ai][bj][m][1][3] *= bfhi(bv.w) * __builtin_amdgcn_rcpf(bfhi(av.w));
                        }
            }
            PG8_LDB(B0, 0, 0); PG8_LDB(B1, 0, 1); PG8_SCHED; PG8_LDA(At, 0, 0); PG8_STAGE(PG8_SA(1, 1), a1 + hstepA, voffA);
            PG8_WAIT_V(8); PG8_WAIT_L(0); PG8_BAR; PG8_MMA(0, 0, At, B0); PG8_MMA(0, 1, At, B1); PG8_BAR; PG8_SCHED;
            PG8_LDA(At, 0, 1); PG8_STAGE(PG8_SB(0, 0), b2, voffB); PG8_STAGE(PG8_SB(0, 1), b2 + hstepB, voffB); PG8_STAGE(PG8_SA(0, 0), a2, voffA);
            PG8_WAIT_V(8); PG8_WAIT_L(0); PG8_BAR; PG8_MMA(1, 0, At, B0); PG8_MMA(1, 1, At, B1); PG8_BAR; PG8_SCHED;
            PG8_LDB(B0, 1, 0); PG8_LDB(B1, 1, 1); PG8_SCHED; PG8_LDA(At, 1, 0); PG8_STAGE(PG8_SA(0, 1), a2 + hstepA, voffA);
            PG8_WAIT_V(8); PG8_WAIT_L(0); PG8_BAR; PG8_MMA(0, 0, At, B0); PG8_MMA(0, 1, At, B1); PG8_BAR; PG8_SCHED;
            PG8_LDA(At, 1, 1); PG8_STAGE(PG8_SB(1, 0), b3, voffB); PG8_STAGE(PG8_SB(1, 1), b3 + hstepB, voffB); PG8_STAGE(PG8_SA(1, 0), a3, voffA);
            PG8_WAIT_V(8); PG8_WAIT_L(0); PG8_BAR; PG8_MMA(1, 0, At, B0); PG8_MMA(1, 1, At, B1); PG8_BAR; PG8_SCHED;
        }
        if (wr == 0) PG8_BAR;
        if (!E.after_drain) { const int tl = lane_id_l(); E.template run<FP8>(acc, cur, wr, wc, tl & 15, tl >> 4, lds); }
        if (!has_next) break;
        float zf2 = 0.f; asm volatile("" : "+v"(zf2));
#pragma unroll
        for (int a = 0; a < 2; ++a)
#pragma unroll
            for (int b = 0; b < 2; ++b)
#pragma unroll
                for (int m = 0; m < 4; ++m)
#pragma unroll
                    for (int n = 0; n < 2; ++n) acc[a][b][m][n] = (f32x4){zf2, zf2, zf2, zf2};
        cur = nxt; cA = nA; cB = nB; ++ui;
        if (wr == 1) PG8_BAR;
    }
    PG8_WAIT_V(0);
    PG8_BAR;
    if constexpr (!FP8) if (E.after_drain) { const int tl = lane_id_l(); E.fused(acc, cur, wr, wc, tl & 15, tl >> 4, lds, wid * 64 + tl); }
#undef PG8_SA
#undef PG8_SB
#undef PG8_STAGE
#undef PG8_STAGE2
#undef PG8_P2_voffA
#undef PG8_P2_voffB
#undef PG8_LDA
#undef PG8_LDB
#undef PG8_MMA
#undef PG8_WAIT_V
#undef PG8_WAIT_L
#undef PG8_BAR
#undef PG8_SCHED
}

#define XB_TMO      128
#define XB_XCNT(j)  (256  + 64 * (j))
#define XB_XSUB(j)  (1280 + 64 * (j))
#define XB_XGEN(j)  (2304 + 64 * (j))
#define XB_TOP      3328
#define XB_TOPGEN   3392
#define XCD_BAR_WORDS 3456
#define XB_SPIN_CAP (1u << 22)
__device__ __forceinline__ unsigned xb_ld(unsigned* p)              { return __hip_atomic_load(p, __ATOMIC_RELAXED, __HIP_MEMORY_SCOPE_AGENT); }
__device__ __forceinline__ unsigned xb_add(unsigned* p, unsigned v) { return __hip_atomic_fetch_add(p, v, __ATOMIC_RELAXED, __HIP_MEMORY_SCOPE_AGENT); }
__device__ __forceinline__ unsigned xb_xcc_id() { return (unsigned)__builtin_amdgcn_s_getreg((3 << 11) | 20) & 0xFu; }
#define XB_SPIN(cond, bar) do { unsigned _sp = 0; while (cond) { __builtin_amdgcn_s_sleep(1); \
    if ((++_sp & 255u) == 0u) { if (xb_ld(&(bar)[XB_TMO])) break; if (_sp > XB_SPIN_CAP) { atomicAdd(&(bar)[XB_TMO], 1u); break; } } } } while (0)
struct XcdBarrier { unsigned* bar; unsigned x; volatile LAS unsigned* st; };
__device__ __forceinline__ XcdBarrier xcd_barrier_post(unsigned* bar, volatile LAS unsigned* st) {
    XcdBarrier b; b.bar = bar; b.x = xb_xcc_id(); b.st = st;
    if (threadIdx.x == 0) (void)xb_add(&bar[XB_XCNT(b.x)], 1u);
    return b;
}
__device__ __forceinline__ void xcd_barrier_complete(unsigned* bar, unsigned x, unsigned& nloc, unsigned& nx) {
    const unsigned G = gridDim.x * gridDim.y * gridDim.z;
    unsigned sum, cnt, mine, sp = 0u;
    for (;;) {
        sum = 0u; cnt = 0u; mine = 0u;
#pragma unroll
        for (unsigned j = 0; j < 16; ++j) { const unsigned c = xb_ld(&bar[XB_XCNT(j)]); sum += c; cnt += (c > 0u) ? 1u : 0u; mine = (j == x) ? c : mine; }
        if (sum == G) break;
        __builtin_amdgcn_s_sleep(1);
        if ((++sp & 255u) == 0u) { if (xb_ld(&bar[XB_TMO])) break; if (sp > XB_SPIN_CAP) { atomicAdd(&bar[XB_TMO], 1u); break; } }
    }
    nloc = mine > 0u ? mine : 1u; nx = cnt > 0u ? cnt : 1u;
}
__device__ __forceinline__ void xcd_barrier(const XcdBarrier& b) {
    asm volatile("s_waitcnt vmcnt(0)" ::: "memory");
    __syncthreads();
    if (threadIdx.x == 0) {
        unsigned* bar = b.bar; asm volatile("" : "+v"(bar));
        __builtin_amdgcn_s_waitcnt(0);
        unsigned nloc = b.st[0], nx = b.st[1];
        if (nloc == 0u) { xcd_barrier_complete(bar, b.x, nloc, nx); b.st[0] = nloc; b.st[1] = nx; }
        const unsigned old = xb_add(&bar[XB_XSUB(b.x)], 1u);
        const unsigned gen = old / nloc;
        if (old + 1u == (gen + 1u) * nloc) {
            __builtin_amdgcn_fence(__ATOMIC_RELEASE, "agent");
            asm volatile("s_waitcnt vmcnt(0)" ::: "memory");
            const unsigned og = xb_add(&bar[XB_TOP], 1u);
            const unsigned tg = og / nx;
            if (og + 1u == (tg + 1u) * nx) xb_add(&bar[XB_TOPGEN], 1u);
            else XB_SPIN(xb_ld(&bar[XB_TOPGEN]) == tg, bar);
            __builtin_amdgcn_fence(__ATOMIC_ACQUIRE, "agent");
            xb_add(&bar[XB_XGEN(b.x)], 1u);
            asm volatile("s_waitcnt vmcnt(0)" ::: "memory");
        } else {
            XB_SPIN(xb_ld(&bar[XB_XGEN(b.x)]) == gen, bar);
            __builtin_amdgcn_fence(__ATOMIC_ACQUIRE, "agent");
            asm volatile("s_waitcnt vmcnt(0)" ::: "memory");
        }
    }
    __syncthreads();
}

__device__ __forceinline__ void transpose_item(const float* W, int K, int N, bf16_t* WT, int ldw, int dst_row0, LAS float* scr, int k0, int n0, int lane, const float* gain = nullptr) {
    const int kr = lane >> 3, c4 = lane & 7;
    f32x4 v[8];
#pragma unroll
    for (int i = 0; i < 8; ++i) v[i] = *(const f32x4*)(W + (size_t)(k0 + kr + 8 * i) * N + n0 + 4 * c4);
    if (gain) {
#pragma unroll
        for (int i = 0; i < 8; ++i) v[i] = v[i] * gain[k0 + kr + 8 * i]; }
#pragma unroll
    for (int i = 0; i < 8; ++i) { LAS float* d = scr + (kr + 8 * i) * 33 + 4 * c4; d[0] = v[i].x; d[1] = v[i].y; d[2] = v[i].z; d[3] = v[i].w; }
    LDS_WAIT(); asm volatile("" ::: "memory");
    const int c = lane & 7;
#pragma unroll
    for (int j = 0; j < 4; ++j) { const int n = (lane >> 3) + 8 * j; const LAS float* s = scr + (8 * c) * 33 + n;
        u32x4 o; o.x = pk2(s[0 * 33], s[1 * 33]); o.y = pk2(s[2 * 33], s[3 * 33]); o.z = pk2(s[4 * 33], s[5 * 33]); o.w = pk2(s[6 * 33], s[7 * 33]);
        *(u32x4*)(WT + (size_t)(dst_row0 + n) * ldw + k0 + 8 * c) = o; }
    LDS_WAIT(); asm volatile("" ::: "memory");
}
__device__ __forceinline__ void tr_plain(const float* W, int K, int N, bf16_t* WT, int ldw, LAS float* scr, int r, int lane, const float* gain = nullptr) {
    const int nblk = N / 32, kb = r / nblk, nb = r % nblk; transpose_item(W, K, N, WT, ldw, 32 * nb, scr, 64 * kb, 32 * nb, lane, gain);
}
__device__ __forceinline__ void tr_pair(const float* W, int K, int N, int col0, int ncols, bf16_t* WT, int half, LAS float* scr, int r, int lane, const float* gain = nullptr) {
    const int nblk = ncols / 32, kb = r / nblk, nb = r % nblk, c = 32 * nb;
    transpose_item(W, K, N, WT, K, 256 * (c >> 7) + (c & 127) + half * 128, scr, 64 * kb, col0 + c, lane, gain);
}
__device__ __forceinline__ void transpose_item_q(const float* W, int K, int N, unsigned char* WT, int dst_row0, LAS float* scr, int k0, int n0, int lane, float scale) {
    const int kr = lane >> 3, c4 = lane & 7;
    f32x4 v[8];
#pragma unroll
    for (int i = 0; i < 8; ++i) v[i] = *(const f32x4*)(W + (size_t)(k0 + kr + 8 * i) * N + n0 + 4 * c4);
#pragma unroll
    for (int i = 0; i < 8; ++i) { LAS float* d = scr + (kr + 8 * i) * 33 + 4 * c4; d[0] = v[i].x; d[1] = v[i].y; d[2] = v[i].z; d[3] = v[i].w; }
    LDS_WAIT(); asm volatile("" ::: "memory");
    const int c = lane & 3;
#pragma unroll
    for (int j = 0; j < 2; ++j) { const int n = (lane >> 2) + 16 * j; const LAS float* s = scr + (16 * c) * 33 + n; float x[16];
#pragma unroll
        for (int e = 0; e < 16; ++e) x[e] = clamp448(s[e * 33] * scale);
        u32x4 o; o.x = pk4_fp8(x[0], x[1], x[2], x[3]); o.y = pk4_fp8(x[4], x[5], x[6], x[7]); o.z = pk4_fp8(x[8], x[9], x[10], x[11]); o.w = pk4_fp8(x[12], x[13], x[14], x[15]);
        *(u32x4*)(WT + (size_t)(dst_row0 + n) * K + k0 + 16 * c) = o; }
    LDS_WAIT(); asm volatile("" ::: "memory");
}
__device__ __forceinline__ void tr_pair_q(const float* W, int K, int N, unsigned char* WT, int half, LAS float* scr, int r, int lane, float scale) {
    const int nblk = N / 32, kb = r / nblk, nb = r % nblk, c = 32 * nb;
    transpose_item_q(W, K, N, WT, 256 * (c >> 7) + (c & 127) + half * 128, scr, 64 * kb, c, lane, scale);
}
__device__ __forceinline__ int sample_sexp(const float* W, int lane) {
    const f32x4 w4 = *(const f32x4*)(W + 4 * lane); float ss = (w4.x * w4.x + w4.y * w4.y) + (w4.z * w4.z + w4.w * w4.w);
    ss = wave_sum(ss, lane); const float rms = sqrtf(ss * (1.f / 256.f));
    int se = 3 - (int)rintf(__builtin_amdgcn_logf(fmaxf(rms, 1e-30f))); return se < -100 ? -100 : (se > 100 ? 100 : se);
}
struct TrDesc { const float* src; unsigned char* dst; const float* gain; int N, ldw, drow0, k0, n0, q; float scale; };
__device__ __forceinline__ void trd_plain(TrDesc& d, const float* W, int N, void* WT, int ldw, int r, const float* gain, int q, float scale) {
    const int nblk = N / 32, kb = r / nblk, nb = r % nblk; d.src = W; d.dst = (unsigned char*)WT; d.gain = gain; d.N = N; d.ldw = ldw; d.drow0 = 32 * nb; d.k0 = 64 * kb; d.n0 = 32 * nb; d.q = q; d.scale = scale; }
__device__ __forceinline__ void trd_pair(TrDesc& d, const float* W, int K, int N, int col0, int ncols, void* WT, int half, int r, const float* gain, int q, float scale) {
    const int nblk = ncols / 32, kb = r / nblk, nb = r % nblk, c = 32 * nb; d.src = W; d.dst = (unsigned char*)WT; d.gain = gain; d.N = N; d.ldw = K; d.drow0 = 256 * (c >> 7) + (c & 127) + half * 128; d.k0 = 64 * kb; d.n0 = col0 + c; d.q = q; d.scale = scale; }
__device__ __forceinline__ void trd_load(const TrDesc& d, f32x4 (&v)[8], int lane) {
    const int kr = lane >> 3, c4 = lane & 7;
#pragma unroll
    for (int i = 0; i < 8; ++i) v[i] = *(const f32x4*)(d.src + (size_t)(d.k0 + kr + 8 * i) * d.N + d.n0 + 4 * c4);
}
__device__ __forceinline__ void trd_finish(const TrDesc& d, f32x4 (&v)[8], LAS float* scr, int lane) {
    const int kr = lane >> 3, c4 = lane & 7;
    if (d.gain) {
#pragma unroll
        for (int i = 0; i < 8; ++i) v[i] = v[i] * d.gain[d.k0 + kr + 8 * i]; }
#pragma unroll
    for (int i = 0; i < 8; ++i) { LAS float* p = scr + (kr + 8 * i) * 33 + 4 * c4; p[0] = v[i].x; p[1] = v[i].y; p[2] = v[i].z; p[3] = v[i].w; }
    LDS_WAIT(); asm volatile("" ::: "memory");
    if (d.q) { const int c = lane & 3;
#pragma unroll
        for (int j = 0; j < 2; ++j) { const int n = (lane >> 2) + 16 * j; const LAS float* s = scr + (16 * c) * 33 + n; float x[16];
#pragma unroll
            for (int e = 0; e < 16; ++e) x[e] = clamp448(s[e * 33] * d.scale);
            u32x4 o; o.x = pk4_fp8(x[0], x[1], x[2], x[3]); o.y = pk4_fp8(x[4], x[5], x[6], x[7]); o.z = pk4_fp8(x[8], x[9], x[10], x[11]); o.w = pk4_fp8(x[12], x[13], x[14], x[15]);
            *(u32x4*)(d.dst + (size_t)(d.drow0 + n) * d.ldw + d.k0 + 16 * c) = o; }
    } else { const int c = lane & 7;
#pragma unroll
        for (int j = 0; j < 4; ++j) { const int n = (lane >> 3) + 8 * j; const LAS float* s = scr + (8 * c) * 33 + n;
            u32x4 o; o.x = pk2(s[0 * 33], s[1 * 33]); o.y = pk2(s[2 * 33], s[3 * 33]); o.z = pk2(s[4 * 33], s[5 * 33]); o.w = pk2(s[6 * 33], s[7 * 33]);
            *(u32x4*)((bf16_t*)d.dst + (size_t)(d.drow0 + n) * d.ldw + d.k0 + 8 * c) = o; }
    }
    LDS_WAIT(); asm volatile("" ::: "memory");
}
__device__ __forceinline__ void rms_row(const float* xrow, const float* gain, bf16_t* orow, int lane, f32x4 (&v)[4], unsigned char* o8row = nullptr) {
    const f32x4* xr = (const f32x4*)xrow + lane; float s = 0.f;
#pragma unroll
    for (int j = 0; j < 4; ++j) { v[j] = xr[64 * j]; s += (v[j].x * v[j].x + v[j].y * v[j].y) + (v[j].z * v[j].z + v[j].w * v[j].w); }
    const float r = 1.0f / sqrtf(wave_sum(s, lane) * (1.f / DM) + EPS);
    const f32x4* gr = (const f32x4*)gain + lane;
    u32x2* o8 = (u32x2*)orow + lane;
#pragma unroll
    for (int j = 0; j < 4; ++j) { const f32x4 g = gr[64 * j]; v[j] = v[j] * r * g; u32x2 w; w.x = pk2(v[j].x, v[j].y); w.y = pk2(v[j].z, v[j].w); o8[64 * j] = w;
        if (o8row) ((unsigned*)o8row)[lane + 64 * j] = pk4_fp8(clamp448(16.f * v[j].x), clamp448(16.f * v[j].y), clamp448(16.f * v[j].z), clamp448(16.f * v[j].w)); }
}

__device__ __forceinline__ void rms_row_b(const bf16_t* xrow, const float* gain, bf16_t* orow, int lane, f32x4 (&v)[4]) {
    const u32x4* xr = (const u32x4*)xrow + lane; float s = 0.f;
#pragma unroll
    for (int j = 0; j < 2; ++j) { const u32x4 r = xr[64 * j]; v[2 * j] = (f32x4){bflo(r.x), bfhi(r.x), bflo(r.y), bfhi(r.y)}; v[2 * j + 1] = (f32x4){bflo(r.z), bfhi(r.z), bflo(r.w), bfhi(r.w)}; }
#pragma unroll
    for (int j = 0; j < 4; ++j) s += (v[j].x * v[j].x + v[j].y * v[j].y) + (v[j].z * v[j].z + v[j].w * v[j].w);
    const float r = 1.0f / sqrtf(wave_sum(s, lane) * (1.f / DM) + EPS);
    u32x4* o8 = (u32x4*)orow + lane;
#pragma unroll
    for (int j = 0; j < 2; ++j) { const f32x4 g0 = *(const f32x4*)(gain + 8 * lane + 512 * j), g1 = *(const f32x4*)(gain + 8 * lane + 512 * j + 4);
        v[2 * j] = v[2 * j] * r * g0; v[2 * j + 1] = v[2 * j + 1] * r * g1;
        u32x4 w; w.x = pk2(v[2 * j].x, v[2 * j].y); w.y = pk2(v[2 * j].z, v[2 * j].w); w.z = pk2(v[2 * j + 1].x, v[2 * j + 1].y); w.w = pk2(v[2 * j + 1].z, v[2 * j + 1].w); o8[64 * j] = w; }
}
__device__ __forceinline__ void rms_row_b_pre(const u32x4 r0, const u32x4 r1, const f32x4 (&g)[4], bf16_t* orow, int lane, f32x4 (&v)[4]) {
    v[0] = (f32x4){bflo(r0.x), bfhi(r0.x), bflo(r0.y), bfhi(r0.y)}; v[1] = (f32x4){bflo(r0.z), bfhi(r0.z), bflo(r0.w), bfhi(r0.w)};
    v[2] = (f32x4){bflo(r1.x), bfhi(r1.x), bflo(r1.y), bfhi(r1.y)}; v[3] = (f32x4){bflo(r1.z), bfhi(r1.z), bflo(r1.w), bfhi(r1.w)};
    float s = 0.f;
#pragma unroll
    for (int j = 0; j < 4; ++j) s += (v[j].x * v[j].x + v[j].y * v[j].y) + (v[j].z * v[j].z + v[j].w * v[j].w);
    const float r = 1.0f / sqrtf(wave_sum(s, lane) * (1.f / DM) + EPS);
    u32x4* o8 = (u32x4*)orow + lane;
#pragma unroll
    for (int j = 0; j < 2; ++j) { v[2 * j] = v[2 * j] * r * g[2 * j]; v[2 * j + 1] = v[2 * j + 1] * r * g[2 * j + 1];
        u32x4 w; w.x = pk2(v[2 * j].x, v[2 * j].y); w.y = pk2(v[2 * j].z, v[2 * j].w); w.z = pk2(v[2 * j + 1].x, v[2 * j + 1].y); w.w = pk2(v[2 * j + 1].z, v[2 * j + 1].w); o8[64 * j] = w; }
}
__device__ __forceinline__ void ssm_table_wave(LAS unsigned char* wl, int lane, int g, int tau, const float* a_re, const float* a_im, const float* log_dt, const float* b_re, const float* b_im,
                                               const float* c_re, const float* c_im, float* Ptab  , float* Ktab  , bf16_t* Winp  ) {
    LAS f32x2* EB = (LAS f32x2*)wl; LAS f32x2* Cc = (LAS f32x2*)(wl + 8192);
    const int p = lane;
    const float dt = __expf(log_dt[g]), ar = a_re[g * 64 + p], ai = a_im[g * 64 + p];
    const float mg = __expf(ar * dt * (float)tau); float tr = ai * dt * (float)tau * 0.15915494309189535f; tr -= rintf(tr);
    const float Er = mg * __builtin_amdgcn_cosf(tr), Ei = mg * __builtin_amdgcn_sinf(tr);
    *(f32x2*)(Ptab + ((size_t)(g * 33 + tau) * 64 + p) * 2) = (f32x2){Er, Ei};
    if (tau >= 32) return;
    const float m1 = __expf(ar * dt); float t1 = ai * dt * 0.15915494309189535f; t1 -= rintf(t1);
    const float nr = m1 * __builtin_amdgcn_cosf(t1) - 1.0f, ni = m1 * __builtin_amdgcn_sinf(t1), den = ar * ar + ai * ai;
    const float fr = (nr * ar + ni * ai) / den, fi = (ni * ar - nr * ai) / den;
    const float efr = Er * fr - Ei * fi, efi = Er * fi + Ei * fr;
#pragma unroll
    for (int c = 0; c < 16; ++c) Cc[c * 64 + p] = (f32x2){c_re[(g * 16 + c) * 64 + p], c_im[(g * 16 + c) * 64 + p]};
    float er[16], ei[16];
#pragma unroll
    for (int j = 0; j < 4; ++j) { const f32x4 br = *(const f32x4*)(b_re + (g * 64 + p) * 16 + 4 * j), bi = *(const f32x4*)(b_im + (g * 64 + p) * 16 + 4 * j);
#pragma unroll
        for (int e = 0; e < 4; ++e) { er[4 * j + e] = efr * br[e] - efi * bi[e]; ei[4 * j + e] = efr * bi[e] + efi * br[e]; EB[p * 16 + 4 * j + e] = (f32x2){er[4 * j + e], ei[4 * j + e]}; } }
    { bf16_t* wp = Winp + ((size_t)(g * 256 + 2 * p)) * 512 + (31 - tau) * 16; u32x4 w0, w1;
      w0.x = pk2(er[0], er[1]); w0.y = pk2(er[2], er[3]); w0.z = pk2(er[4], er[5]); w0.w = pk2(er[6], er[7]); w1.x = pk2(er[8], er[9]); w1.y = pk2(er[10], er[11]); w1.z = pk2(er[12], er[13]); w1.w = pk2(er[14], er[15]);
      *(u32x4*)wp = w0; *(u32x4*)(wp + 8) = w1;
      w0.x = pk2(ei[0], ei[1]); w0.y = pk2(ei[2], ei[3]); w0.z = pk2(ei[4], ei[5]); w0.w = pk2(ei[6], ei[7]); w1.x = pk2(ei[8], ei[9]); w1.y = pk2(ei[10], ei[11]); w1.z = pk2(ei[12], ei[13]); w1.w = pk2(ei[14], ei[15]);
      *(u32x4*)(wp + 512) = w0; *(u32x4*)(wp + 512 + 8) = w1; }
    LDS_WAIT(); asm volatile("" ::: "memory");
    const int cp = lane & 15, cq = lane >> 4; float s0 = 0.f, s1 = 0.f, s2 = 0.f, s3 = 0.f;
#pragma unroll 4
    for (int q = 0; q < 64; ++q) { const f32x2 eb = EB[q * 16 + cp]; const f32x2 c0 = Cc[cq * 64 + q], c1 = Cc[(cq + 4) * 64 + q], c2 = Cc[(cq + 8) * 64 + q], c3 = Cc[(cq + 12) * 64 + q];
        s0 += c0.x * eb.x - c0.y * eb.y; s1 += c1.x * eb.x - c1.y * eb.y; s2 += c2.x * eb.x - c2.y * eb.y; s3 += c3.x * eb.x - c3.y * eb.y; }
    float* kp = Ktab + ((size_t)(g * 32 + tau)) * 256 + cp;
    kp[cq * 16] = s0; kp[(cq + 4) * 16] = s1; kp[(cq + 8) * 16] = s2; kp[(cq + 12) * 16] = s3;
    LDS_WAIT(); asm volatile("" ::: "memory");
}
__device__ __forceinline__ void ssm_expand_row(int rr, int lane, const float* Ptab, const float* Ktab, const float* c_re, const float* c_im, const float* dskip  , bf16_t* W) {
    const int g = rr >> 9, tc = rr & 511, t = tc >> 4, c = tc & 15, s = lane;
    bf16_t* dst = W + (size_t)rr * 640;
    if (s < 32) {
        f32x4 k4[4];
        if (s <= t) { const f32x4* kp = (const f32x4*)(Ktab + ((size_t)(g * 32 + (t - s))) * 256 + c * 16);
#pragma unroll
            for (int j = 0; j < 4; ++j) k4[j] = kp[j];
            if (s == t) { const float dk = dskip[g * 16 + c];
#pragma unroll
                for (int j = 0; j < 4; ++j)
#pragma unroll
                    for (int e = 0; e < 4; ++e) k4[j][e] += (4 * j + e == c) ? dk : 0.f; }
        } else {
#pragma unroll
            for (int j = 0; j < 4; ++j) k4[j] = (f32x4){0.f, 0.f, 0.f, 0.f};
        }
        u32x4 w0, w1; w0.x = pk2(k4[0].x, k4[0].y); w0.y = pk2(k4[0].z, k4[0].w); w0.z = pk2(k4[1].x, k4[1].y); w0.w = pk2(k4[1].z, k4[1].w);
        w1.x = pk2(k4[2].x, k4[2].y); w1.y = pk2(k4[2].z, k4[2].w); w1.z = pk2(k4[3].x, k4[3].y); w1.w = pk2(k4[3].z, k4[3].w);
        *(u32x4*)(dst + s * 16) = w0; *(u32x4*)(dst + s * 16 + 8) = w1;
    }
    const int p = lane; const float cr = c_re[(g * 16 + c) * 64 + p], ci = c_im[(g * 16 + c) * 64 + p];
    const f32x2 P = *(const f32x2*)(Ptab + ((size_t)(g * 33 + t + 1) * 64 + p) * 2);
    *(unsigned*)(dst + 512 + 2 * p) = pk2(cr * P.x - ci * P.y, -(cr * P.y + ci * P.x));
}

template <int HD, int MODE>
__device__ __forceinline__ void attn_stage(LAS unsigned char* lds, int tid, const bf16_t* Kp, const bf16_t* Vp, long kv_rstride, int first_valid,
                                           const float* gk, const float* ropeK, long rope_stride) {
    constexpr int CPR = HD / 8, PIECES = 256 * CPR / 512, PB = PIECES < 4 ? PIECES : 4;
    const int c = tid % CPR, lane = tid & 63;
    float gkv[8];
    { const f32x4 g0 = *(const f32x4*)(gk + c * 8), g1 = *(const f32x4*)(gk + c * 8 + 4); gkv[0] = g0.x; gkv[1] = g0.y; gkv[2] = g0.z; gkv[3] = g0.w; gkv[4] = g1.x; gkv[5] = g1.y; gkv[6] = g1.z; gkv[7] = g1.w; }
    (void)ropeK; (void)rope_stride;
#pragma nounroll
    for (int ib = 0; ib < PIECES; ib += PB) {
        u32x4 kv[PB], vv[PB];
#pragma unroll
        for (int i = 0; i < PB; ++i) { const int key = tid / CPR + (512 / CPR) * (ib + i), kk = key < first_valid ? first_valid : key;
            kv[i] = *(const u32x4*)(Kp + (long)kk * kv_rstride + c * 8); vv[i] = *(const u32x4*)(Vp + (long)kk * kv_rstride + c * 8); }
#pragma unroll
        for (int i = 0; i < PB; ++i) { const int key = tid / CPR + (512 / CPR) * (ib + i);
            float x[8] = {bflo(kv[i].x), bfhi(kv[i].x), bflo(kv[i].y), bfhi(kv[i].y), bflo(kv[i].z), bfhi(kv[i].z), bflo(kv[i].w), bfhi(kv[i].w)};
            float ss = 0.f;
#pragma unroll
            for (int e = 0; e < 8; ++e) ss += x[e] * x[e];
#pragma unroll
            for (int o = 1; o < CPR; o <<= 1) ss += shx(ss, o, lane);
            const float r = (MODE == 0) ? 1.0f : 1.0f / sqrtf(ss * (1.f / HD) + EPS);
#pragma unroll
            for (int e = 0; e < 8; ++e) x[e] = (MODE == 0) ? x[e] : x[e] * r * gkv[e];
            u32x4 w; w.x = pk2(x[0], x[1]); w.y = pk2(x[2], x[3]); w.z = pk2(x[4], x[5]); w.w = pk2(x[6], x[7]);
            *(LAS u32x4*)(lds + (c * 256 + key) * 16) = w;
            *(LAS u32x4*)(lds + 256 * HD * 2 + ((c >> 1) * 256 + key) * 32 + (c & 1) * 16) = vv[i]; }
    }
}
__device__ __forceinline__ void attn_dma64(LAS unsigned char* lds, int buf, int wave, int lane, const bf16_t* Kp, const bf16_t* Vp, long kv_rstride, int first_valid) {
#pragma unroll
    for (int i = 0; i < 4; ++i) { const int P = wave * 4 + i, c = P >> 2, kg = P & 3; int key = kg * 64 + lane; key = key < first_valid ? first_valid : key;
        __builtin_amdgcn_global_load_lds((const unsigned*)(Kp + (long)key * kv_rstride + c * 8), (LAS unsigned*)(lds + buf + (c * 256 + kg * 64) * 16), 16, 0, 0); }
#pragma unroll
    for (int i = 0; i < 4; ++i) { const int P = wave * 4 + i, dt = P >> 3, kg = P & 7; int key = kg * 32 + (lane >> 1); key = key < first_valid ? first_valid : key;
        __builtin_amdgcn_global_load_lds((const unsigned*)(Vp + (long)key * kv_rstride + dt * 16 + (lane & 1) * 8), (LAS unsigned*)(lds + buf + 32768 + (dt * 256 + kg * 32) * 32), 16, 0, 0); }
}
struct NextDma { int has, buf, fv; const bf16_t* Kp; const bf16_t* Vp; long stride; };
template <int HD, int MODE>
__device__ __forceinline__ void attn_compute(LAS unsigned char* lds, int wid, int lane, const bf16_t* Qp, long q_rstride, const float* gq, const float* ropeQ, long rope_stride,
                                             int first_valid, bf16_t* Op, long o_rstride, float* lsep, long lse_stride, LAS unsigned char* lds0 = nullptr, const NextDma nd = NextDma{0, 0, 0, nullptr, nullptr, 0}) {
    constexpr int KS = HD / 32, DT = HD / 16;
    constexpr int NKT = (MODE == 0) ? 9 : 16, NG = (MODE == 0) ? 5 : 8;
    const int kt0 = (MODE == 0) ? wid : 0;
    const int qn = lane & 15, kq = lane >> 4;
    const float SC = (HD == 64 ? 0.125f : 0.08838834764831845f) * LOG2E;
    bf16x8 qf[KS];
    {
        const bf16_t* qrow = Qp + (long)(16 * wid + qn) * q_rstride;
        float x[KS][8]; float ss = 0.f;
#pragma unroll
        for (int ks = 0; ks < KS; ++ks) { const u32x4 q4 = *(const u32x4*)(qrow + 32 * ks + 8 * kq);
            x[ks][0] = bflo(q4.x); x[ks][1] = bfhi(q4.x); x[ks][2] = bflo(q4.y); x[ks][3] = bfhi(q4.y); x[ks][4] = bflo(q4.z); x[ks][5] = bfhi(q4.z); x[ks][6] = bflo(q4.w); x[ks][7] = bfhi(q4.w);
#pragma unroll
            for (int e = 0; e < 8; ++e) ss += x[ks][e] * x[ks][e]; }
        ss += shx(ss, 16, lane); ss += shx(ss, 32, lane);
        const float r = SC / sqrtf(ss * (1.f / HD) + EPS);
        if (MODE != 0) {
#pragma unroll
        for (int ks = 0; ks < KS; ++ks)
#pragma unroll
            for (int e = 0; e < 8; ++e) x[ks][e] = x[ks][e] * r * gq[32 * ks + 8 * kq + e]; }
        if (false) {
            const f32x4* rp = (const f32x4*)(ropeQ + (long)(16 * wid + qn) * rope_stride + kq * 16);
#pragma unroll
            for (int j = 0; j < 4; ++j) { const f32x4 t4 = rp[j];
                { const float x1 = x[0][2 * j], x2 = x[KS - 1][2 * j]; x[0][2 * j] = x1 * t4.x - x2 * t4.y; x[KS - 1][2 * j] = x1 * t4.y + x2 * t4.x; }
                { const float x1 = x[0][2 * j + 1], x2 = x[KS - 1][2 * j + 1]; x[0][2 * j + 1] = x1 * t4.z - x2 * t4.w; x[KS - 1][2 * j + 1] = x1 * t4.w + x2 * t4.z; } }
        }
#pragma unroll
        for (int ks = 0; ks < KS; ++ks) { u32x4 w; w.x = pk2(x[ks][0], x[ks][1]); w.y = pk2(x[ks][2], x[ks][3]); w.z = pk2(x[ks][4], x[ks][5]); w.w = pk2(x[ks][6], x[ks][7]); qf[ks] = __builtin_bit_cast(bf16x8, w); }
    }
    if (MODE != 0) __builtin_amdgcn_sched_barrier(0);
    if (MODE == 0 && nd.has) attn_dma64(lds0, nd.buf, wid, lane, nd.Kp, nd.Vp, nd.stride, nd.fv);
    f32x4 s[NKT];
    const LAS unsigned char* kb = lds + (kq * 256 + 16 * kt0 + qn) * 16;
#pragma unroll
    for (int i = 0; i < NKT; ++i) { s[i] = (f32x4){0.f, 0.f, 0.f, 0.f};
#pragma unroll
        for (int ks = 0; ks < KS; ++ks) { const bf16x8 kf = *(const LAS bf16x8*)(kb + (4 * ks * 256 + 16 * i) * 16); s[i] = __builtin_amdgcn_mfma_f32_16x16x32_bf16(kf, qf[ks], s[i], 0, 0, 0); }
        if (MODE != 0 && (i & 3) == 3) __builtin_amdgcn_sched_barrier(0); }
    if (MODE == 0) {
        const int qq = 16 * wid + qn;
#pragma unroll
        for (int i = 0; i < NKT; ++i)
#pragma unroll
            for (int e = 0; e < 4; ++e) { const int ki = 16 * (kt0 + i) + 4 * kq + e; const bool ok = (ki >= qq) && (ki <= qq + 128) && (ki >= first_valid); if (!ok) s[i][e] = -1e30f; }
    }
    float mx = -3.0e38f;
#pragma unroll
    for (int i = 0; i < NKT; ++i)
#pragma unroll
        for (int e = 0; e < 4; ++e) mx = fmaxf(mx, s[i][e]);
    mx = fmaxf(mx, shx(mx, 16, lane)); mx = fmaxf(mx, shx(mx, 32, lane));
    float l = 0.f;
#pragma unroll
    for (int i = 0; i < NKT; ++i)
#pragma unroll
        for (int e = 0; e < 4; ++e) { const float p = __builtin_amdgcn_exp2f(s[i][e] - mx); s[i][e] = p; l += p; }
    l += shx(l, 16, lane); l += shx(l, 32, lane);
    bf16x8 pf[NG];
#pragma unroll
    for (int G = 0; G < NG; ++G) { u32x4 w; w.x = pk2(s[2 * G][0], s[2 * G][1]); w.y = pk2(s[2 * G][2], s[2 * G][3]);
        if (2 * G + 1 < NKT) { w.z = pk2(s[2 * G + 1][0], s[2 * G + 1][1]); w.w = pk2(s[2 * G + 1][2], s[2 * G + 1][3]); } else { w.z = 0u; w.w = 0u; }
        pf[G] = __builtin_bit_cast(bf16x8, w); }
    f32x4 o[DT];
#pragma unroll
    for (int dt = 0; dt < DT; ++dt) o[dt] = (f32x4){0.f, 0.f, 0.f, 0.f};
    const int q4 = qn >> 2, pp = qn & 3;
    const LAS unsigned char* vb = lds + 256 * HD * 2 + (16 * kt0 + 4 * kq + q4) * 32 + pp * 8;
#pragma unroll
    for (int G = 0; G < NG; ++G)
#pragma unroll
        for (int dt = 0; dt < DT; ++dt) {
            const int t1 = (2 * G + 1 < NKT) ? 2 * G + 1 : 2 * G;
            const s16x4 lo = __builtin_bit_cast(s16x4, __builtin_amdgcn_ds_read_tr16_b64_v4i16((LAS s16x4*)(vb + (dt * 256 + 32 * G) * 32)));
            const s16x4 hi = __builtin_bit_cast(s16x4, __builtin_amdgcn_ds_read_tr16_b64_v4i16((LAS s16x4*)(vb + (dt * 256 + 16 * t1) * 32)));
            const bf16x8 vf = (bf16x8){lo[0], lo[1], lo[2], lo[3], hi[0], hi[1], hi[2], hi[3]};
            o[dt] = __builtin_amdgcn_mfma_f32_16x16x32_bf16(pf[G], vf, o[dt], 0, 0, 0);
        }
    float linv[4];
#pragma unroll
    for (int e = 0; e < 4; ++e) linv[e] = 1.0f / shi(l, 4 * kq + e, lane);
#pragma unroll
    for (int e = 0; e < 4; ++e) { bf16_t* orow = Op + (long)(16 * wid + 4 * kq + e) * o_rstride + qn;
#pragma unroll
        for (int dt = 0; dt < DT; ++dt) orow[16 * dt] = (bf16_t)(pk2(o[dt][e] * linv[e], 0.f) & 0xffffu); }
    if (MODE == 0 && kq == 0) lsep[(long)(16 * wid + qn) * lse_stride] = (mx + __builtin_amdgcn_logf(l)) * LN2;
}


struct Args { const void* in[32]; float* out; unsigned char* ws; int lo, hi, mask, pad; };
enum { MSK_ATT = 1, MSK_MEM = 2, MSK_SSM = 4, MSK_FFN = 8, MSK_MOE = 16 };
constexpr int ST_LAYER0 = 4, ST_PER_LAYER = 16, ST_END = ST_LAYER0 + 2 * ST_PER_LAYER;

__global__ void __launch_bounds__(NWAVES * 64, 2) mega(Args args) {
    extern __shared__ __attribute__((aligned(16))) unsigned char lds_raw[];
    LAS unsigned char* lds = (LAS unsigned char*)lds_raw;
    const int tid0 = threadIdx.x; const int wave0 = __builtin_amdgcn_readfirstlane(tid0 >> 6);
    const int G0 = gridDim.x, bx0 = blockIdx.x, vcu0 = (G0 % 8 == 0) ? (bx0 % 8) * (G0 / 8) + bx0 / 8 : bx0, mask0 = args.mask;
    for (int u = tid0; u < (LDS_BYTES - LDSCTL_OFF) / 4; u += NWAVES * 64) ((LAS unsigned*)(lds + LDSCTL_OFF))[u] = 0u;
    if (tid0 == 0) {
#pragma unroll
        for (int k = 0; k < 32; ++k) *(volatile LAS unsigned long long*)(lds + LDSPTR_OFF + 8 * k) = (unsigned long long)args.in[k];
        *(volatile LAS unsigned long long*)(lds + LDSPTR_OFF + 8 * 32) = (unsigned long long)args.out;
        *(volatile LAS unsigned long long*)(lds + LDSPTR_OFF + 8 * 33) = (unsigned long long)args.ws;
    }
    __syncthreads();
    (void)xcd_barrier_post((unsigned*)(args.ws + WS_CTL) + 4096, (volatile LAS unsigned*)(lds + LDSCTL_OFF + 64));

    int dry = 0, reps = 0;
    for (int st = args.lo; st < args.hi; ++st) {
        int Gi = G0, vcu = vcu0, bx = bx0, mask = mask0; asm volatile("" : "+s"(Gi), "+s"(vcu), "+s"(bx), "+s"(mask));
        const int G = Gi, NGW = Gi * NWAVES;
        const int lane = lane_id_l(), wave = wave0, tid = wave0 * 64 + lane;
        const int gw = vcu * NWAVES + wave;
        LAS float* wscr = (LAS float*)(lds + wave * 16384);
        unsigned char* ws = lds_ptr<unsigned char>(lds, 33);
        float* ROPE = (float*)(ws + WS_ROPE);
        bf16_t* HN = (bf16_t*)(ws + WS_A); bf16_t* Yb = (bf16_t*)(ws + WS_A); bf16_t* H2 = (bf16_t*)(ws + WS_A); bf16_t* XS = (bf16_t*)(ws + WS_XS);
        bf16_t* QKV = (bf16_t*)(ws + WS_B); bf16_t* MERGED = (bf16_t*)(ws + WS_B + 16 * MiB); bf16_t* CAT = (bf16_t*)(ws + WS_CAT);
        bf16_t* XQ = (bf16_t*)(ws + WS_C); bf16_t* Gt = (bf16_t*)(ws + WS_D); bf16_t* HID = (bf16_t*)(ws + WS_D); bf16_t* Ut = (bf16_t*)(ws + WS_E);
        bf16_t* OG = (bf16_t*)(ws + WS_F); float* LSE = (float*)(ws + WS_F + 24 * MiB);
        bf16_t* SSMW = (bf16_t*)(ws + WS_SSMW);
        int* mt_nt = (int*)(ws + WS_META + MT_NT); int* mt_texp = (int*)(ws + WS_META + MT_TEXP); int* mt_toke = (int*)(ws + WS_META + MT_TOKE);
        float* mt_tokw = (float*)(ws + WS_META + MT_TOKW); int* mt_pos = (int*)(ws + WS_META + MT_POS); float* mt_roww = (float*)(ws + WS_META + MT_ROWW);
        bf16_t* MOEW = (bf16_t*)(ws + WS_MOEW); bf16_t* MOEWD = (bf16_t*)(ws + WS_MOEWD); bf16_t* MOEH = (bf16_t*)(ws + WS_MOEH); bf16_t* MOEA = (bf16_t*)(ws + WS_MOEA);

        bool do_gemm = false, do_bar = true, do_fp8 = false, post_expand = false;
        Gemm gm; Sched S; Epi E;
        gm.A = nullptr; gm.Bt = nullptr; gm.lda = 0; gm.ldb = 0; gm.K = 0;
        S.mode = 0; S.nM = 0; S.nN = 0; S.nwg = 0; S.G = G; S.c = bx; S.pn0 = 0; S.nfull = 0; S.texp = mt_texp;
        E.mode = EP_BF16; E.perm = 1; E.after_drain = 0; E.o0 = nullptr; E.o1 = nullptr; E.o2 = nullptr; E.o3 = nullptr; E.ldo = 0; E.gt = nullptr; E.fo = nullptr; E.fr = nullptr; E.ptab = nullptr; E.x8 = nullptr; E.xb = nullptr; E.ssq = nullptr; E.ssqr = nullptr;
        const int l = (st >= ST_LAYER0 + ST_PER_LAYER) ? 1 : 0;
        const int ls = (st >= ST_LAYER0) ? (st - ST_LAYER0 - l * ST_PER_LAYER) : -1;
        { unsigned lo_ = LDSCTL_OFF + 256 + 4 * wave; asm volatile("" : "+s"(lo_)); *(volatile LAS int*)(lds + lo_) = l; }
        bf16_t* WL = (bf16_t*)(ws + WS_WL + (size_t)l * WL_STRIDE);
        float* Ptab_l = (float*)(ws + WS_SSMT + (size_t)l * 4 * MiB); float* Ktab_l = (float*)(ws + WS_SSMT + (size_t)l * 4 * MiB + 2 * MiB);
        bf16_t* Winp_l = (bf16_t*)(ws + WS_WINP + (size_t)l * 16 * MiB);
        bf16_t* KVM_l = (bf16_t*)(ws + WS_KVM + (size_t)l * 2 * MiB);

        if (st == 0) {
            { const float* a_re = INF(5); const float* a_im = INF(6); const float* log_dt = INF(7); const float* b_re = INF(8); const float* b_im = INF(9); const float* c_re = INF(10); const float* c_im = INF(11);
            for (int it = gw; it < 2 * 32 * 33; it += NGW) { const int ll = it / (32 * 33), r = it % (32 * 33), g = r / 33, tau = r % 33;
                ssm_table_wave(lds + wave * 16384, lane, g, tau, a_re + ll * 2048, a_im + ll * 2048, log_dt + ll * 32, b_re + ll * 32768, b_im + ll * 32768, c_re + ll * 32768, c_im + ll * 32768,
                               (float*)(ws + WS_SSMT + (size_t)ll * 4 * MiB), (float*)(ws + WS_SSMT + (size_t)ll * 4 * MiB + 2 * MiB), (bf16_t*)(ws + WS_WINP + (size_t)ll * 16 * MiB)); } }
            {
                constexpr int PER_L = 5120, NIT = 2 * PER_L + 3 * 1408;
                const float* w_in = INF(4); const float* w_glu = INF(13); const float* w_ssm_out = INF(14); const float* w_att_out = INF(17); const float* w_mem_kv = INF(19); const float* w_mem_out = INF(22); const float* w_o = INF(23);
                const float* ffn_g = INF(25); const float* ffn_u = INF(26); const float* ffn_d = INF(27);
                const float* nm1 = INF(3) + DM; const float* nf0 = INF(24);
                const int gse0 = sample_sexp(w_in, lane), gse1 = sample_sexp(w_in + (size_t)DM * INC, lane); const float gsc0 = __builtin_amdgcn_exp2f((float)gse0), gsc1 = __builtin_amdgcn_exp2f((float)gse1);
                if (gw == 0 && lane == 0) { int* se = (int*)(ws + WS_META + MT_SEXP); float* si = (float*)(ws + WS_META + MT_SINV); se[27] = gse0; se[28] = gse1; si[27] = __builtin_amdgcn_exp2f(-(float)gse0); si[28] = __builtin_amdgcn_exp2f(-(float)gse1); }
#define TR_DECODE0(it_, d) do { int r = (it_); \
                    if (r < 2 * PER_L) { const int ll = r / PER_L; r %= PER_L; bf16_t* W = (bf16_t*)(ws + WS_WL + (size_t)ll * WL_STRIDE); \
                        if (r < 3200) { trd_plain(d, w_in + (size_t)ll * DM * INC, INC, W + WL_IN / 2, DM, r, ll ? nm1 : nullptr, 0, 1.f); \
                            if (r % 200 >= 104) { d.q = 1; d.scale = ll ? gsc1 : gsc0; d.dst = (unsigned char*)W + WL_IN + (size_t)3328 * DM * 2; d.drow0 -= 3328; } \
                            else if (r % 200 >= 16 && r % 200 < 64) { const int c0_ = 32 * (r % 200), w_ = c0_ & 255; d.drow0 = (c0_ & ~255) + 128 * ((w_ >> 5) & 1) + 32 * (w_ >> 6); } break; } r -= 3200; \
                        if (r < 256) { const int half = r >= 128; trd_pair(d, w_glu + (size_t)ll * 512 * 1024, 512, 1024, half * 512, 512, W + WL_GLU / 2, half, r & 127, nullptr, 0, 1.f); break; } r -= 256; \
                        if (r < 256) { trd_plain(d, w_ssm_out + (size_t)ll * 512 * DM, DM, W + WL_CAT / 2, 1280, r, nullptr, 0, 1.f); break; } r -= 256; \
                        if (r < 128) { trd_plain(d, w_att_out + (size_t)ll * 256 * DM, DM, W + WL_CAT / 2 + 512, 1280, r, nullptr, 0, 1.f); break; } r -= 128; \
                        if (r < 512) { trd_plain(d, w_mem_kv + (size_t)ll * DM * 1024, 1024, W + WL_MKV / 2, DM, r, nullptr, 0, 1.f); break; } r -= 512; \
                        if (r < 256) { trd_plain(d, w_mem_out + (size_t)ll * 512 * DM, DM, W + WL_CAT / 2 + 768, 1280, r, nullptr, 0, 1.f); break; } r -= 256; \
                        trd_plain(d, w_o + (size_t)ll * DM * DM, DM, W + WL_WO / 2, DM, r, nullptr, 0, 1.f); break; } \
                    r -= 2 * PER_L; \
                    if (r < 1408) { trd_pair(d, ffn_g, DM, DFF, 0, DFF, ws + WS_FFN, 0, r, nf0, 0, 1.f); break; } r -= 1408; \
                    if (r < 1408) { trd_pair(d, ffn_u, DM, DFF, 0, DFF, ws + WS_FFN, 1, r, nf0, 0, 1.f); break; } r -= 1408; \
                    trd_plain(d, ffn_d, DM, ws + WS_FFND, DFF, r, nullptr, 0, 1.f); } while (0)
                TrDesc d0{}, d1{}; f32x4 va[8], vb[8];
#pragma unroll
                for (int i = 0; i < 8; ++i) { va[i] = (f32x4){0.f, 0.f, 0.f, 0.f}; vb[i] = va[i]; }
                if (gw < NIT) { TR_DECODE0(gw, d0); trd_load(d0, va, lane); }
                for (int it = gw; it < NIT; it += NGW) {
                    const bool has = it + NGW < NIT;
                    if (has) { TR_DECODE0(it + NGW, d1); trd_load(d1, vb, lane); }
                    trd_finish(d0, va, wscr, lane);
                    if (has) { d0 = d1;
#pragma unroll
                        for (int i = 0; i < 8; ++i) va[i] = vb[i]; }
                }
            }
            { const float* x_in = INF(0); const float* mem = INF(1); const float* norm_mix = INF(3); const float* norm_mem = INF(18);
            for (int m = gw; m < NT + 2048; m += NGW) { f32x4 v[4];
                if (m < NT) rms_row(x_in + (size_t)m * DM, norm_mix, HN + (size_t)m * DM, lane, v, ws + WS_F + (size_t)m * DM);
                else { const int mm = m - NT, ll = mm >> 10, rr = mm & 1023; rms_row(mem + (size_t)rr * DM, norm_mem + ll * DM, (bf16_t*)(ws + WS_MEMN + (size_t)ll * 2 * MiB) + (size_t)rr * DM, lane, v); } } }
            { const int* pos = lds_ptr<const int>(lds, 2);
            for (int m = gw; m < NT; m += NGW) { if (lane < 32) { const float inv = exp2f(-(float)lane * (13.287712379549449f / 32.f)); const float ang = (float)pos[m] * inv; float sn, cs; sincosf(ang, &sn, &cs);
                    *(f32x2*)(ROPE + (size_t)m * 64 + 2 * lane) = (f32x2){cs, sn}; } } }
            for (int z = gw; z < 8192; z += NGW) { const int ll = z >> 12, g = (z >> 7) & 31, r = 128 + (z & 127);
                bf16_t* p = (bf16_t*)(ws + WS_WINP + (size_t)ll * 16 * MiB) + ((size_t)(g * 256 + r)) * 512 + lane * 8;
                unsigned zz = 0u; asm volatile("" : "+v"(zz)); *(u32x4*)p = (u32x4){zz, zz, zz, zz}; }
        } else if (st == 1) {
            {
                const float* c_re = INF(10); const float* c_im = INF(11); const float* ssm_d = INF(12);
                const int w0 = gw, nw = NGW;
                for (int rr = w0; rr < 16384; rr += nw) ssm_expand_row(rr, lane, (const float*)(ws + WS_SSMT), (const float*)(ws + WS_SSMT + 2 * MiB), c_re, c_im, ssm_d, SSMW); }
        } else if (st == 2 || st == 3) {
            do_bar = false;
        } else if (ls == 0 || ls == 3) {
            gm.A = (l == 0) ? HN : XS; gm.Bt = WL + WL_IN / 2; gm.lda = DM; gm.ldb = DM; gm.K = DM;
            const bool split = (G == 256);
            if (ls == 0) { S.mode = 0; S.nM = NT / 256; S.nN = split ? 12 : 13; S.nwg = S.nM * S.nN; }
            else { S.mode = 0; S.nM = NT / 256; S.nN = 1; S.nwg = split ? 64 : 0; S.pn0 = 12; S.c = (bx + G - 64) % G; }
            E.mode = EP_INPROJ; E.o0 = Ut; E.o1 = QKV; E.o2 = XQ; E.o3 = Gt; if (l == 1) E.ssqr = (const float*)(ws + WS_SSQ);
            do_gemm = true; do_bar = false;
        } else if (ls == 1) {
            gm.A = (const bf16_t*)(ws + WS_F); gm.Bt = (const bf16_t*)((unsigned char*)WL + WL_IN + (size_t)3328 * DM * 2); gm.lda = DM; gm.ldb = DM; gm.K = DM;
            S.mode = 0; S.nM = NT / 256; S.nN = 12; S.nwg = S.nM * 12;
            E.mode = EP_GATEQ; E.o3 = Gt; if (l == 1) E.ssqr = (const float*)(ws + WS_SSQ);
            do_gemm = true; do_fp8 = true;
        } else if (ls == 2) {
            if (mask & MSK_SSM) {
                gm.A = Ut; gm.Bt = Winp_l; gm.lda = 640; gm.ldb = 512; gm.K = 512;
                S.mode = 5; S.nM = 64; S.nN = 1; S.nwg = 64;
                E.mode = EP_ZSCAN; E.perm = 0; E.after_drain = 1; E.o0 = Ut; E.ptab = Ptab_l;
                do_gemm = true; }
            do_bar = false;
        } else if (ls == 4 || ls == 6) {
            const int r = vcu & 31, grp = vcu >> 5;
            if (mask & MSK_ATT) {
                const float* att_qn = INF(15); const float* att_kn = INF(16);
                int u0, u1;
                if (G == 256) {
                    if (l == 0) {
                        if (ls == 4) { u0 = grp * 132 + (r < 4 ? 4 * r : (r < 16 ? 16 + 3 * (r - 4) : (r < 20 ? 52 + 2 * (r - 16) : 60 + 6 * (r - 20)))); u1 = u0 + (r < 4 ? 4 : (r < 16 ? 3 : (r < 20 ? 2 : 6))); }
                        else { u0 = 1056 + grp * 60 + (r < 8 ? 3 * r : (r < 16 ? 24 + 2 * (r - 8) : (r < 20 ? 40 + 2 * (r - 16) : 48 + (r - 20)))); u1 = u0 + (r < 8 ? 3 : (r < 20 ? 2 : 1)); }
                    } else {
                        if (ls == 4) { u0 = grp * 148 + (r < 4 ? 4 * r : (r < 16 ? 16 + 3 * (r - 4) : 52 + 6 * (r - 16))); u1 = u0 + (r < 4 ? 4 : (r < 16 ? 3 : 6)); }
                        else { u0 = 1184 + grp * 44 + (r < 8 ? 3 * r : (r < 16 ? 24 + 2 * (r - 8) : 40 + (r < 20 ? r - 16 : 4))); u1 = u0 + (r < 8 ? 3 : (r < 16 ? 2 : (r < 20 ? 1 : 0))); } }
                } else { const int per = (1536 + G - 1) / G; u0 = (ls == 4) ? vcu * per : 1536; u1 = (ls == 4) ? ((u0 + per < 1536) ? u0 + per : 1536) : 1536; }
#define DIL_DECODE(uid_, h, g, d, tok0, tokk, fv) const int b_ = (uid_) / 384, rem_ = (uid_) % 384, h = rem_ >> 5, blk_ = rem_ & 31, g = h >> 2, d = 1 << (2 * g), nbpr_ = 32 >> (2 * g), rr_ = blk_ / nbpr_, nb_ = blk_ % nbpr_; \
                    const long tok0 = (long)b_ * SEQ + (long)nb_ * 128 * d + rr_, tokk = tok0 - (long)128 * d; const int fv = (nb_ == 0) ? 128 : 0
                __syncthreads();
                if (u0 < u1) { DIL_DECODE(u0, h, g, d, tok0, tokk, fv); attn_dma64(lds, 0, wave, lane, QKV + tokk * 2304 + 768 + h * 64, QKV + tokk * 2304 + 1536 + h * 64, (long)d * 2304, fv); }
                for (int uid = u0; uid < u1; ++uid) {
                    DIL_DECODE(uid, h, g, d, tok0, tokk, fv);
                    NextDma nd; nd.has = (uid + 1 < u1) ? 1 : 0; nd.buf = ((uid + 1 - u0) & 1) * 65536; nd.fv = 0; nd.Kp = nullptr; nd.Vp = nullptr; nd.stride = 0;
                    if (nd.has) { DIL_DECODE(uid + 1, h2, g2, d2, tok02, tokk2, fv2); (void)g2; (void)tok02; nd.fv = fv2; nd.Kp = QKV + tokk2 * 2304 + 768 + h2 * 64; nd.Vp = QKV + tokk2 * 2304 + 1536 + h2 * 64; nd.stride = (long)d2 * 2304; }
                    asm volatile("s_waitcnt vmcnt(0)" ::: "memory"); __syncthreads();
                    attn_compute<64, 0>(lds + ((uid - u0) & 1) * 65536, wave, lane, QKV + tok0 * 2304 + h * 64, (long)d * 2304, nullptr, nullptr, 0, fv,
                                        OG + ((long)g * NT + tok0) * 256 + (h & 3) * 64, (long)d * 256, LSE + ((long)g * NT + tok0) * 4 + (h & 3), (long)d * 4, lds, nd);
                }
                asm volatile("s_waitcnt vmcnt(0)" ::: "memory");
#undef DIL_DECODE
            }
            if (ls == 6 && (mask & MSK_MEM)) {
                const float* mem_qn = INF(20); const float* mem_kn = INF(21);
                int m0 = vcu, m1 = 256, ms = G;
                if (G == 256) { if (r >= 16) { m0 = 2 * (grp * 16 + (r - 16)); m1 = m0 + 2; } else { m0 = 0; m1 = 0; } ms = 1; }
                int staged = -1;
                for (int uid = m0; uid < m1; uid += ms) {
                    const int b = uid >> 6, h = (uid >> 4) & 3, qb = uid & 15; const int lnl = lane_id_l(), tidl = wave * 64 + lnl;
                    const bf16_t* Kp = KVM_l + ((size_t)b * 256) * 1024 + h * 128;
                    if (staged != (uid >> 4)) {
                        __syncthreads();
                        attn_stage<128, 1>(lds, tidl, Kp, Kp + 512, 1024, 0, mem_kn + l * 128, nullptr, 0);
                        __syncthreads(); staged = uid >> 4; }
                    for (int qs = 0; qs < 2; ++qs) { const long tok0 = (long)b * SEQ + qb * 256 + qs * 128;
                        attn_compute<128, 1>(lds, wave, lnl, XQ + tok0 * 512 + h * 128, 512, mem_qn + l * 128, nullptr, 0, 0, CAT + tok0 * 1280 + 768 + h * 128, 1280, nullptr, 0); }
                }
            }
            __syncthreads();
            if (l == 0 && ls == 4) {
                gm.A = (const bf16_t*)(ws + WS_MEMN); gm.Bt = (const bf16_t*)(ws + WS_WL + WL_MKV); gm.lda = DM; gm.ldb = DM; gm.K = DM;
                S.mode = 3; S.nM = 8; S.nN = 4; S.nwg = 32; if (G == 256) S.c = (bx + G - 128) % G;
                E.mode = EP_BF16; E.o0 = (bf16_t*)(ws + WS_KVM); E.ldo = 1024;
                do_gemm = true; }
        } else if (ls == 5) {
            if (mask & MSK_SSM) {
                gm.A = Ut; gm.Bt = SSMW; gm.lda = 640; gm.ldb = 640; gm.K = 640;
                S.mode = 5; S.nM = 64; S.nN = 2; S.nwg = 128;
                E.mode = EP_SSMOUT; E.o0 = Yb;
                do_gemm = true; }
            do_bar = false;
        } else if (ls == 7) {
            if (mask & MSK_ATT) {
                for (int idx = vcu * 512 + tid; idx < NT * 32; idx += G * 512) {
                    const int tok = idx >> 5, ch = idx & 31, slot = ch >> 3;
                    const float l0 = LSE[((size_t)0 * NT + tok) * 4 + slot], l1 = LSE[((size_t)1 * NT + tok) * 4 + slot], l2 = LSE[((size_t)2 * NT + tok) * 4 + slot];
                    const float m = fmaxf(fmaxf(l0, l1), l2); float e0 = __expf(l0 - m), e1 = __expf(l1 - m), e2 = __expf(l2 - m); const float inv = 1.f / (e0 + e1 + e2); e0 *= inv; e1 *= inv; e2 *= inv;
                    const u32x4 v0 = *(const u32x4*)(OG + ((size_t)0 * NT + tok) * 256 + ch * 8), v1 = *(const u32x4*)(OG + ((size_t)1 * NT + tok) * 256 + ch * 8), v2 = *(const u32x4*)(OG + ((size_t)2 * NT + tok) * 256 + ch * 8);
                    u32x4 w;
                    w.x = pk2(e0 * bflo(v0.x) + e1 * bflo(v1.x) + e2 * bflo(v2.x), e0 * bfhi(v0.x) + e1 * bfhi(v1.x) + e2 * bfhi(v2.x));
                    w.y = pk2(e0 * bflo(v0.y) + e1 * bflo(v1.y) + e2 * bflo(v2.y), e0 * bfhi(v0.y) + e1 * bfhi(v1.y) + e2 * bfhi(v2.y));
                    w.z = pk2(e0 * bflo(v0.z) + e1 * bflo(v1.z) + e2 * bflo(v2.z), e0 * bfhi(v0.z) + e1 * bfhi(v1.z) + e2 * bfhi(v2.z));
                    w.w = pk2(e0 * bflo(v0.w) + e1 * bflo(v1.w) + e2 * bflo(v2.w), e0 * bfhi(v0.w) + e1 * bfhi(v1.w) + e2 * bfhi(v2.w));
                    *(u32x4*)(CAT + (size_t)tok * 1280 + 512 + ch * 8) = w;
                }
            }
            if (mask & MSK_SSM) {
                gm.A = Yb; gm.Bt = WL + WL_GLU / 2; gm.lda = 512; gm.ldb = 512; gm.K = 512;
                S.mode = 0; S.nM = NT / 256; S.nN = 4; S.nwg = 256;
                E.mode = EP_GLU; E.o0 = CAT; E.ldo = 1280;
                do_gemm = true; }
        } else if (ls == 8) {
            gm.A = CAT; gm.Bt = WL + WL_CAT / 2; gm.lda = 1280; gm.ldb = 1280; gm.K = 1280;
            S.mode = 0; S.nM = NT / 256; S.nN = 4; S.nwg = 256;
            E.mode = EP_MERGEF; E.o0 = MERGED; E.gt = Gt;
            do_gemm = true;
        } else if (ls == 9) {
            gm.A = MERGED; gm.Bt = WL + WL_WO / 2; gm.lda = DM; gm.ldb = DM; gm.K = DM;
            S.mode = 0; S.nM = NT / 256; S.nN = 4; S.nwg = 256;
            E.mode = EP_RESID; E.fr = (l == 0) ? INF(0) : nullptr; E.xb = XS; E.ssq = (float*)(ws + WS_SSQ);
            do_gemm = true;
        } else if (ls == 10) {
            float* out = lds_ptr<float>(lds, 32); const float* norm_ffn = INF(24); const float* moe_r = INF(28);
            if (l == 0) do_bar = false;
            else {
                f32x4 wr0[16], wr1[16];
#pragma unroll
                for (int j = 0; j < 4; ++j)
#pragma unroll
                    for (int i = 0; i < 4; ++i) { const int k = 8 * lane + 512 * (j >> 1) + 4 * (j & 1) + i; wr0[4 * j + i] = *(const f32x4*)(moe_r + k * 8); wr1[4 * j + i] = *(const f32x4*)(moe_r + k * 8 + 4); }
                f32x4 gn[4];
#pragma unroll
                for (int j = 0; j < 2; ++j) { gn[2 * j] = *(const f32x4*)(norm_ffn + l * DM + 8 * lane + 512 * j); gn[2 * j + 1] = *(const f32x4*)(norm_ffn + l * DM + 8 * lane + 512 * j + 4); }
                u32x4 nx0 = (u32x4){0u, 0u, 0u, 0u}, nx1 = nx0;
                if (gw < NT) { const u32x4* xr = (const u32x4*)(XS + (size_t)gw * DM) + lane; nx0 = xr[0]; nx1 = xr[64]; }
                for (int m = gw; m < NT; m += NGW) { f32x4 v[4]; const u32x4 cx0 = nx0, cx1 = nx1;
                    if (m + NGW < NT) { const u32x4* xr = (const u32x4*)(XS + (size_t)(m + NGW) * DM) + lane; nx0 = xr[0]; nx1 = xr[64]; }
                    rms_row_b_pre(cx0, cx1, gn, H2 + (size_t)m * DM, lane, v);
                    float lg[8];
#pragma unroll
                    for (int e = 0; e < 8; ++e) lg[e] = 0.f;
#pragma unroll
                    for (int j = 0; j < 4; ++j)
#pragma unroll
                        for (int i = 0; i < 4; ++i) { const f32x4 w0 = wr0[4 * j + i], w1 = wr1[4 * j + i]; const float h = v[j][i];
                            lg[0] += h * w0.x; lg[1] += h * w0.y; lg[2] += h * w0.z; lg[3] += h * w0.w; lg[4] += h * w1.x; lg[5] += h * w1.y; lg[6] += h * w1.z; lg[7] += h * w1.w; }
                    float a4[4];
#pragma unroll
                    for (int e = 0; e < 4; ++e) { const float keep = (lane & 32) ? lg[4 + e] : lg[e], send = (lane & 32) ? lg[e] : lg[4 + e]; a4[e] = keep + shx(send, 32, lane); }
                    float a2[2];
#pragma unroll
                    for (int e = 0; e < 2; ++e) { const float keep = (lane & 16) ? a4[2 + e] : a4[e], send = (lane & 16) ? a4[e] : a4[2 + e]; a2[e] = keep + shx(send, 16, lane); }
                    float a1; { const float keep = (lane & 8) ? a2[1] : a2[0], send = (lane & 8) ? a2[0] : a2[1]; a1 = keep + shx(send, 8, lane); }
                    a1 += shx(a1, 4, lane); a1 += shx(a1, 2, lane); a1 += shx(a1, 1, lane);
#pragma unroll
                    for (int e = 0; e < 8; ++e) lg[e] = shi(a1, 8 * e, lane);
                    int i0 = 0; float v0 = lg[0];
#pragma unroll
                    for (int e = 1; e < 8; ++e) if (lg[e] > v0) { v0 = lg[e]; i0 = e; }
                    int i1 = 0; float v1 = -3.4e38f;
#pragma unroll
                    for (int e = 0; e < 8; ++e) if (e != i0 && lg[e] > v1) { v1 = lg[e]; i1 = e; }
                    const float e1 = __expf(v1 - v0);
                    if (lane == 0) { mt_toke[m] = i0 | (i1 << 8); *(f32x2*)(mt_tokw + 2 * m) = (f32x2){1.f / (1.f + e1), e1 / (1.f + e1)}; }
                } }
            asm volatile("" ::: "memory");
            if (l == 1 && gw < 24) {
                const float* Wm = (gw >= 16) ? INF(31) + (size_t)(gw - 16) * DFE * DM : ((gw & 1) ? INF(30) : INF(29)) + (size_t)(gw >> 1) * DM * DFE; const int ldw = (gw >= 16) ? DM : DFE; float ss = 0.f;
#pragma unroll
                for (int k = 0; k < 16; ++k) { const f32x4 w4 = *(const f32x4*)(Wm + (size_t)k * ldw + 4 * lane); ss += (w4.x * w4.x + w4.y * w4.y) + (w4.z * w4.z + w4.w * w4.w); }
                ss = wave_sum(ss, lane); const float rms = sqrtf(ss * (1.f / 4096.f));
                int se = 3 - (int)rintf(__builtin_amdgcn_logf(fmaxf(rms, 1e-30f))); se = se < -100 ? -100 : (se > 100 ? 100 : se);
                if (lane == 0) { ((int*)(ws + WS_META + MT_SEXP))[gw] = se; ((float*)(ws + WS_META + MT_SINV))[gw] = __builtin_amdgcn_exp2f(-(float)se); } }
        } else if (l == 0 && ls == 11) {
            if (mask & MSK_FFN) {
                gm.A = XS; gm.Bt = (const bf16_t*)(ws + WS_FFN); gm.lda = DM; gm.ldb = DM; gm.K = DM;
                S.mode = 0; S.nM = NT / 256; S.nN = 22; S.nwg = S.nM * S.nN;
                E.mode = EP_SWIGLU; E.o0 = HID; E.ldo = DFF; E.ssqr = (const float*)(ws + WS_SSQ);
                do_gemm = true; }
            post_expand = true;
        } else if (l == 0 && ls == 12) {
            if (mask & MSK_FFN) {
                gm.A = HID; gm.Bt = (const bf16_t*)(ws + WS_FFND); gm.lda = DFF; gm.ldb = DFF; gm.K = DFF;
                S.mode = 0; S.nM = NT / 256; S.nN = 4; S.nwg = 256;
                E.mode = EP_RESID; E.fr = nullptr; E.xb = XS; E.ssq = (float*)(ws + WS_SSQ); E.x8 = ws + WS_F;
                do_gemm = true; }
        } else if (l == 0 && ls >= 13) {
            do_bar = false;
        } else if (l == 1 && ls == 11) {
            if (mask & MSK_MOE) {
                if (vcu == 0) {
                    LAS int* cnt = (LAS int*)(lds + 131072 - 256); LAS int* base = cnt + 8; LAS int* fill = cnt + 16;
                    if (tid < 8) { cnt[tid] = 0; fill[tid] = 0; }
                    __syncthreads();
                    for (int tok = tid; tok < NT; tok += 512) { const int ee = mt_toke[tok]; __hip_atomic_fetch_add(cnt + (ee & 255), 1, __ATOMIC_RELAXED, __HIP_MEMORY_SCOPE_WORKGROUP); __hip_atomic_fetch_add(cnt + (ee >> 8), 1, __ATOMIC_RELAXED, __HIP_MEMORY_SCOPE_WORKGROUP); }
                    __syncthreads();
                    if (tid == 0) { int off = 0;
#pragma nounroll
                        for (int e = 0; e < 8; ++e) { base[e] = off; const int tiles = (cnt[e] + 255) >> 8;
#pragma nounroll
                            for (int j = 0; j < tiles; ++j) mt_texp[(off >> 8) + j] = e;
                            off += tiles * 256; }
                        __hip_atomic_store(mt_nt, off >> 8, __ATOMIC_RELAXED, __HIP_MEMORY_SCOPE_AGENT); }
                    __syncthreads();
                    for (int tok = tid; tok < NT; tok += 512) { const int ee = mt_toke[tok]; const int e0 = ee & 255, e1 = ee >> 8; const f32x2 w = *(const f32x2*)(mt_tokw + 2 * tok);
                        const int p0 = base[e0] + __hip_atomic_fetch_add(fill + e0, 1, __ATOMIC_RELAXED, __HIP_MEMORY_SCOPE_WORKGROUP);
                        const int p1 = base[e1] + __hip_atomic_fetch_add(fill + e1, 1, __ATOMIC_RELAXED, __HIP_MEMORY_SCOPE_WORKGROUP);
                        mt_pos[2 * tok] = p0; mt_pos[2 * tok + 1] = p1; mt_roww[p0] = w.x; mt_roww[p1] = w.y; }
                    __syncthreads();
                }
                const float* moe_g = INF(29); const float* moe_u = INF(30); const float* moe_d = INF(31);
                if (vcu != 0 || G == 1) {
                    const int* sx = (const int*)(ws + WS_META + MT_SEXP);
#define TR_DECODE1(it_, d) do { const int e = (it_) / 5376; int r = (it_) % 5376; \
                        if (r < 1792) { trd_pair(d, moe_g + (size_t)e * DM * DFE, DM, DFE, 0, DFE, (unsigned char*)MOEW + (size_t)e * 7168 * DM, 0, r, nullptr, 1, __builtin_amdgcn_exp2f((float)sx[2 * e])); break; } r -= 1792; \
                        if (r < 1792) { trd_pair(d, moe_u + (size_t)e * DM * DFE, DM, DFE, 0, DFE, (unsigned char*)MOEW + (size_t)e * 7168 * DM, 1, r, nullptr, 1, __builtin_amdgcn_exp2f((float)sx[2 * e + 1])); break; } r -= 1792; \
                        trd_plain(d, moe_d + (size_t)e * DFE * DM, DM, (unsigned char*)MOEWD + (size_t)e * DM * DFE, DFE, r, nullptr, 1, __builtin_amdgcn_exp2f((float)sx[16 + e])); } while (0)
                    const int it0 = (G == 1) ? gw : gw - NWAVES, itn = (G == 1) ? NGW : NGW - NWAVES, NITM = 8 * 5376;
                    TrDesc d0{}, d1{}; f32x4 va[8], vb[8];
#pragma unroll
                for (int i = 0; i < 8; ++i) { va[i] = (f32x4){0.f, 0.f, 0.f, 0.f}; vb[i] = va[i]; }
                    if (it0 < NITM) { TR_DECODE1(it0, d0); trd_load(d0, va, lane); }
                    for (int it = it0; it < NITM; it += itn) {
                        const bool has = it + itn < NITM;
                        if (has) { TR_DECODE1(it + itn, d1); trd_load(d1, vb, lane); }
                        trd_finish(d0, va, wscr, lane);
                        if (has) { d0 = d1;
#pragma unroll
                            for (int i = 0; i < 8; ++i) va[i] = vb[i]; }
                    }
                }
            }
        } else if (l == 1 && ls == 12) {
            if (mask & MSK_MOE) {
                float* rsa = (float*)(ws + WS_META + MT_RSA);
                for (int m = gw; m < NT; m += NGW) { const int p0 = mt_pos[2 * m], p1 = mt_pos[2 * m + 1];
                    const u32x4* src = (const u32x4*)(H2 + (size_t)m * DM) + 2 * lane; const u32x4 a = src[0], b = src[1];
                    float x[16] = {bflo(a.x), bfhi(a.x), bflo(a.y), bfhi(a.y), bflo(a.z), bfhi(a.z), bflo(a.w), bfhi(a.w), bflo(b.x), bfhi(b.x), bflo(b.y), bfhi(b.y), bflo(b.z), bfhi(b.z), bflo(b.w), bfhi(b.w)};
                    float mx = 0.f;
#pragma unroll
                    for (int e = 0; e < 16; ++e) mx = fmaxf(mx, fabsf(x[e]));
#pragma unroll
                    for (int o = 1; o < 64; o <<= 1) mx = fmaxf(mx, shx(mx, o, lane));
                    const int ex = (int)((__float_as_uint(mx) >> 23) & 255u) - 127;
                    const int kk = (mx > 1e-30f) ? (7 - ex) : 0;
                    const float sc = __builtin_amdgcn_exp2f((float)kk), si = __builtin_amdgcn_exp2f(-(float)kk);
#pragma unroll
                    for (int e = 0; e < 16; ++e) x[e] *= sc;
                    u32x4 q; q.x = pk4_fp8(x[0], x[1], x[2], x[3]); q.y = pk4_fp8(x[4], x[5], x[6], x[7]); q.z = pk4_fp8(x[8], x[9], x[10], x[11]); q.w = pk4_fp8(x[12], x[13], x[14], x[15]);
                    *((u32x4*)((unsigned char*)MOEA + (size_t)p0 * DM) + lane) = q; *((u32x4*)((unsigned char*)MOEA + (size_t)p1 * DM) + lane) = q;
                    if (lane == 0) { rsa[p0] = si; rsa[p1] = si; } }
            }
        } else if (l == 1 && ls == 13) {
            if (mask & MSK_MOE) {
                const int ntile = __builtin_amdgcn_readfirstlane(__hip_atomic_load(mt_nt, __ATOMIC_RELAXED, __HIP_MEMORY_SCOPE_AGENT));
                gm.A = MOEA; gm.Bt = MOEW; gm.lda = DM; gm.ldb = DM; gm.K = DM;
                S.mode = 2; S.nM = ntile; S.nN = 28; S.nwg = ntile * 28;
                E.mode = EP_SWIGLUQ; E.o0 = MOEH; E.ldo = DFE;
                do_gemm = true; do_fp8 = true; }
        } else if (l == 1 && ls == 14) {
            if (mask & MSK_MOE) {
                const int ntile = __builtin_amdgcn_readfirstlane(__hip_atomic_load(mt_nt, __ATOMIC_RELAXED, __HIP_MEMORY_SCOPE_AGENT));
                gm.A = MOEH; gm.Bt = MOEWD; gm.lda = DFE; gm.ldb = DFE; gm.K = DFE;
                const int nfull = ntile < 128 ? ntile : 128;
                S.mode = 4; S.nM = ntile; S.nN = 4; S.nfull = nfull; S.nwg = nfull * 4 + (ntile - nfull) * 16;
                E.mode = EP_MOEDOWNQ; E.o0 = MOEA; E.o1 = MOEW;
                do_gemm = true; do_fp8 = true; }
        } else if (l == 1 && ls == 15) {
            if (mask & MSK_MOE) {
                float* out = lds_ptr<float>(lds, 32);
                for (int m = gw; m < NT; m += 2 * NGW) {
                    const int m2 = (m + NGW < NT) ? m + NGW : m;
                    const int p0 = mt_pos[2 * m], p1 = mt_pos[2 * m + 1], q0 = mt_pos[2 * m2], q1 = mt_pos[2 * m2 + 1];
                    const u32x4* c0 = (const u32x4*)(MOEA + (size_t)p0 * DM) + lane; const u32x4* c1 = (const u32x4*)(MOEA + (size_t)p1 * DM) + lane;
                    const u32x4* d0 = (const u32x4*)(MOEA + (size_t)q0 * DM) + lane; const u32x4* d1 = (const u32x4*)(MOEA + (size_t)q1 * DM) + lane;
                    f32x4* xw = (f32x4*)(out + (size_t)m * DM) + 2 * lane; f32x4* yw = (f32x4*)(out + (size_t)m2 * DM) + 2 * lane;
                    const u32x4* xo = (const u32x4*)(XS + (size_t)m * DM) + lane; const u32x4* yo = (const u32x4*)(XS + (size_t)m2 * DM) + lane;
                    u32x4 ca[2], cb[2], da[2], db[2]; f32x4 x[4], y[4];
#pragma unroll
                    for (int j = 0; j < 2; ++j) { ca[j] = c0[64 * j]; cb[j] = c1[64 * j]; da[j] = d0[64 * j]; db[j] = d1[64 * j]; const u32x4 xr = xo[64 * j], yr = yo[64 * j];
                        x[2 * j] = (f32x4){0.f, 0.f, 0.f, 0.f}; x[2 * j + 1] = x[2 * j]; y[2 * j] = x[2 * j]; y[2 * j + 1] = x[2 * j];
                        if (p0 >= 32768 || p1 >= 32768 || q0 >= 32768 || q1 >= 32768) {
#pragma unroll
                            for (int sl = 0; sl < 3; ++sl) { const bf16_t* sb = MOEW + (size_t)sl * 2048 * DM;
                                if (p0 >= 32768) { const u32x4 t = *((const u32x4*)(sb + (size_t)(p0 - 32768) * DM) + lane + 64 * j); x[2 * j] += (f32x4){bflo(t.x), bfhi(t.x), bflo(t.y), bfhi(t.y)}; x[2 * j + 1] += (f32x4){bflo(t.z), bfhi(t.z), bflo(t.w), bfhi(t.w)}; }
                                if (p1 >= 32768) { const u32x4 t = *((const u32x4*)(sb + (size_t)(p1 - 32768) * DM) + lane + 64 * j); x[2 * j] += (f32x4){bflo(t.x), bfhi(t.x), bflo(t.y), bfhi(t.y)}; x[2 * j + 1] += (f32x4){bflo(t.z), bfhi(t.z), bflo(t.w), bfhi(t.w)}; }
                                if (q0 >= 32768) { const u32x4 t = *((const u32x4*)(sb + (size_t)(q0 - 32768) * DM) + lane + 64 * j); y[2 * j] += (f32x4){bflo(t.x), bfhi(t.x), bflo(t.y), bfhi(t.y)}; y[2 * j + 1] += (f32x4){bflo(t.z), bfhi(t.z), bflo(t.w), bfhi(t.w)}; }
                                if (q1 >= 32768) { const u32x4 t = *((const u32x4*)(sb + (size_t)(q1 - 32768) * DM) + lane + 64 * j); y[2 * j] += (f32x4){bflo(t.x), bfhi(t.x), bflo(t.y), bfhi(t.y)}; y[2 * j + 1] += (f32x4){bflo(t.z), bfhi(t.z), bflo(t.w), bfhi(t.w)}; } } }
                        x[2 * j] += (f32x4){bflo(xr.x), bfhi(xr.x), bflo(xr.y), bfhi(xr.y)}; x[2 * j + 1] += (f32x4){bflo(xr.z), bfhi(xr.z), bflo(xr.w), bfhi(xr.w)};
                        y[2 * j] += (f32x4){bflo(yr.x), bfhi(yr.x), bflo(yr.y), bfhi(yr.y)}; y[2 * j + 1] += (f32x4){bflo(yr.z), bfhi(yr.z), bflo(yr.w), bfhi(yr.w)}; }
#pragma unroll
                    for (int j = 0; j < 2; ++j) { const u32x4 a = ca[j], b = cb[j]; f32x4 x0 = x[2 * j], x1 = x[2 * j + 1];
                        x0.x += bflo(a.x) + bflo(b.x); x0.y += bfhi(a.x) + bfhi(b.x); x0.z += bflo(a.y) + bflo(b.y); x0.w += bfhi(a.y) + bfhi(b.y);
                        x1.x += bflo(a.z) + bflo(b.z); x1.y += bfhi(a.z) + bfhi(b.z); x1.z += bflo(a.w) + bflo(b.w); x1.w += bfhi(a.w) + bfhi(b.w);
                        xw[128 * j] = x0; xw[128 * j + 1] = x1; }
                    if (m2 != m) {
#pragma unroll
                        for (int j = 0; j < 2; ++j) { const u32x4 a = da[j], b = db[j]; f32x4 x0 = y[2 * j], x1 = y[2 * j + 1];
                            x0.x += bflo(a.x) + bflo(b.x); x0.y += bfhi(a.x) + bfhi(b.x); x0.z += bflo(a.y) + bflo(b.y); x0.w += bfhi(a.y) + bfhi(b.y);
                            x1.x += bflo(a.z) + bflo(b.z); x1.y += bfhi(a.z) + bfhi(b.z); x1.z += bflo(a.w) + bflo(b.w); x1.w += bfhi(a.w) + bfhi(b.w);
                            yw[128 * j] = x0; yw[128 * j + 1] = x1; } }
                }
            }
        }
        if (do_gemm) { if (do_fp8) gemm_phase<true>(lds, wave, gm, S, E); else gemm_phase<false>(lds, wave, gm, S, E); }
        if (post_expand) {
            const int nfree = (G == 256) ? 128 : G, b0 = (G == 256) ? 128 : 0;
            if (bx >= b0) { const float* c_re = INF(10); const float* c_im = INF(11); const float* ssm_d = INF(12);
                for (int rr = (bx - b0) * NWAVES + wave; rr < 16384; rr += nfree * NWAVES) ssm_expand_row(rr, lane, (const float*)(ws + WS_SSMT + 4 * MiB), (const float*)(ws + WS_SSMT + 6 * MiB), c_re + 32768, c_im + 32768, ssm_d + 512, SSMW); } }
        if (PROBE_HI > PROBE_LO && st == PROBE_HI - 1) { if (reps < PROBE_N) { ++reps; dry = 1; st = PROBE_LO - 1; do_bar = true; } else dry = 0; }
        if (do_bar && st + 1 < args.hi) { XcdBarrier bb; bb.bar = (unsigned*)(lds_ptr<unsigned char>(lds, 33) + WS_CTL) + 4096; bb.x = xb_xcc_id(); bb.st = (volatile LAS unsigned*)(lds + LDSCTL_OFF + 64); xcd_barrier(bb); }
    }
}
}

template <int MODE>
static void ngemm(hipStream_t st, const float* A, int lda, const float* B, int ldb, float* C, int ldc, int M, int N, int K, const float* aux = nullptr, int ldaux = 0) {
    hipLaunchKernelGGL((nv::k_gemm<MODE>), dim3(N / 128, M / 128), dim3(256), 0, st, A, lda, B, ldb, C, ldc, K, aux, ldaux);
}
static void cvt(hipStream_t st, const float* src, void* dst, size_t n, int cols, int ldd) { hipLaunchKernelGGL(nv::k_cvt_f2b, dim3((unsigned)((n + 255) / 256)), dim3(256), 0, st, src, (unsigned short*)dst, n, cols, ldd); }

extern "C" void kernel_launch(void* const* d_in, const int* in_sizes, int n_in, void* d_out, int out_size, void* d_ws, size_t ws_size, hipStream_t stream) {
    using namespace mk;
    static int grid = 0;
    if (grid == 0) {
        if (n_in != 32 || ws_size < WS_END) { fprintf(stderr, "kernel_launch: unexpected n_in %d / ws %zu\n", n_in, ws_size); grid = -1; return; }
        int dev = 0, cus = 0;
        if (hipGetDevice(&dev) != hipSuccess || hipDeviceGetAttribute(&cus, hipDeviceAttributeMultiprocessorCount, dev) != hipSuccess) { grid = -1; return; }
        if (hipFuncSetAttribute((const void*)mega, hipFuncAttributeMaxDynamicSharedMemorySize, LDS_BYTES) != hipSuccess) { fprintf(stderr, "kernel_launch: hipFuncSetAttribute failed\n"); grid = -1; return; }
        int per_cu = 0;
        if (hipOccupancyMaxActiveBlocksPerMultiprocessor(&per_cu, (const void*)mega, NWAVES * 64, LDS_BYTES) != hipSuccess || per_cu < 1) fprintf(stderr, "kernel_launch: occupancy query says %d\n", per_cu);
        (void)hipGetLastError();
        grid = cus;
    }
    if (grid < 0) return;
    unsigned char* ws = (unsigned char*)d_ws;
    Args a{};
    for (int i = 0; i < 32; ++i) a.in[i] = d_in[i];
    a.out = (float*)d_out; a.ws = ws;
    a.mask = (FAST_ATT ? MSK_ATT : 0) | (FAST_MEM ? MSK_MEM : 0) | (FAST_SSM ? MSK_SSM : 0) | (FAST_FFN ? MSK_FFN : 0) | (FAST_MOE ? MSK_MOE : 0);
    auto launch = [&](int lo, int hi) {
        hipMemsetAsync(ws + WS_CTL, 0, CTL_BYTES, stream);
        a.lo = lo; a.hi = hi;
        hipLaunchKernelGGL(mega, dim3(grid), dim3(NWAVES * 64), LDS_BYTES, stream, a);
    };
    constexpr bool ALL_FAST = FAST_ATT && FAST_MEM && FAST_SSM && FAST_FFN && FAST_MOE;
    if (ALL_FAST) { launch(0, ST_END); return; }

    const float* x_in = (const float*)d_in[0]; const float* mem = (const float*)d_in[1]; const int* pos = (const int*)d_in[2];
    const float* norm_mix = (const float*)d_in[3]; const float* w_in = (const float*)d_in[4];
    const float* a_re = (const float*)d_in[5]; const float* a_im = (const float*)d_in[6]; const float* log_dt = (const float*)d_in[7];
    const float* b_re = (const float*)d_in[8]; const float* b_im = (const float*)d_in[9]; const float* c_re = (const float*)d_in[10]; const float* c_im = (const float*)d_in[11];
    const float* ssm_d = (const float*)d_in[12]; const float* w_glu = (const float*)d_in[13];
    const float* att_qn = (const float*)d_in[15]; const float* att_kn = (const float*)d_in[16];
    const float* norm_mem = (const float*)d_in[18]; const float* w_mem_kv = (const float*)d_in[19]; const float* mem_qn = (const float*)d_in[20]; const float* mem_kn = (const float*)d_in[21];
    const float* norm_ffn = (const float*)d_in[24];
    const float* ffn_g = (const float*)d_in[25]; const float* ffn_u = (const float*)d_in[26]; const float* ffn_d = (const float*)d_in[27];
    const float* moe_r = (const float*)d_in[28]; const float* moe_g = (const float*)d_in[29]; const float* moe_u = (const float*)d_in[30]; const float* moe_d = (const float*)d_in[31];
    float* out = (float*)d_out;
    float* bufH = (float*)(ws + WS_NAIVE);
    float* big = (float*)(ws + WS_NAIVE + 16 * MiB);
    float* gate = (float*)(ws + WS_NAIVE + 72 * MiB);
    const int R = 4096;
    launch(0, ST_LAYER0);
    for (int l = 0; l < 2; ++l) {
        const int base = ST_LAYER0 + l * ST_PER_LAYER;
        const float* xcur = (l == 0) ? x_in : out;
        const float* Win = w_in + (size_t)l * DM * INC;
        launch(base + 0, base + 6);
        if (!(FAST_ATT && FAST_MEM && FAST_SSM)) {
            for (int b = 0; b < 4; ++b) {
                hipLaunchKernelGGL(nv::k_rmsnorm, dim3(R * 64 / 256), dim3(256), 0, stream, xcur + (size_t)b * R * DM, norm_mix + l * DM, bufH, R);
                if (!FAST_SSM) {
                    float* U = big; float* Y = big + (size_t)R * 512; float* GA = big + (size_t)R * 1024; float* S = big + (size_t)R * 2048;
                    ngemm<0>(stream, bufH, DM, Win, INC, U, 512, R, 512, DM);
                    hipLaunchKernelGGL(nv::k_ssm, dim3(32), dim3(64), 0, stream, U, Y, a_re + l * 2048, a_im + l * 2048, log_dt + l * 32, b_re + l * 32768, b_im + l * 32768, c_re + l * 32768, c_im + l * 32768, ssm_d + l * 512);
                    ngemm<0>(stream, Y, 512, w_glu + (size_t)l * 512 * 1024, 1024, GA, 1024, R, 1024, 512);
                    hipLaunchKernelGGL(nv::k_glu, dim3(R * 512 / 256), dim3(256), 0, stream, GA, S, R * 512);
                    cvt(stream, S, ws + WS_CAT + (size_t)b * R * 1280 * 2, (size_t)R * 512, 512, 1280);
                }
                if (!FAST_ATT) {
                    float* QKVf = big; float* OGf = big + (size_t)R * 2304; float* AOf = big + (size_t)R * 3072; float* LSEf = big + (size_t)R * 3328;
                    ngemm<0>(stream, bufH, DM, Win + 512, INC, QKVf, 2304, R, 2304, DM);
                    hipLaunchKernelGGL((nv::k_headnorm<64, true>), dim3(R * 12 * 64 / 256), dim3(256), 0, stream, QKVf, 2304, 0, 12, R, att_qn + l * 64, pos + b * R);
                    hipLaunchKernelGGL((nv::k_headnorm<64, true>), dim3(R * 12 * 64 / 256), dim3(256), 0, stream, QKVf, 2304, 768, 12, R, att_kn + l * 64, pos + b * R);
                    hipLaunchKernelGGL(nv::k_dilattn, dim3(R * 12 * 64 / 256), dim3(256), 0, stream, QKVf, OGf, LSEf, R);
                    hipLaunchKernelGGL(nv::k_attmerge, dim3(R * 256 / 256), dim3(256), 0, stream, OGf, LSEf, AOf, R);
                    cvt(stream, AOf, ws + WS_CAT + ((size_t)b * R * 1280 + 512) * 2, (size_t)R * 256, 256, 1280);
                }
                if (!FAST_MEM) {
                    float* XQf = big; float* MOf = big + (size_t)R * 512; float* KVf = big + (size_t)R * 1024; float* MEMNf = KVf + 256 * 1024;
                    hipLaunchKernelGGL(nv::k_rmsnorm, dim3(256 * 64 / 256), dim3(256), 0, stream, mem + (size_t)b * 256 * DM, norm_mem + l * DM, MEMNf, 256);
                    ngemm<0>(stream, MEMNf, DM, w_mem_kv + (size_t)l * DM * 1024, 1024, KVf, 1024, 256, 1024, DM);
                    hipLaunchKernelGGL((nv::k_headnorm<128, false>), dim3(256 * 4 * 64 / 256), dim3(256), 0, stream, KVf, 1024, 0, 4, 256, mem_kn + l * 128, (const int*)nullptr);
                    ngemm<0>(stream, bufH, DM, Win + 2816, INC, XQf, 512, R, 512, DM);
                    hipLaunchKernelGGL((nv::k_headnorm<128, false>), dim3(R * 4 * 64 / 256), dim3(256), 0, stream, XQf, 512, 0, 4, R, mem_qn + l * 128, (const int*)nullptr);
                    hipLaunchKernelGGL(nv::k_memattn, dim3(R * 4 * 64 / 256), dim3(256), 0, stream, XQf, KVf, MOf, R);
                    cvt(stream, MOf, ws + WS_CAT + ((size_t)b * R * 1280 + 768) * 2, (size_t)R * 512, 512, 1280);
                }
            }
        }
        launch(base + 6, base + 11);
        if (l == 0) {
            if (FAST_FFN) launch(base + 11, base + 14);
            else {
                for (int b = 0; b < 4; ++b) {
                    float* ob = out + (size_t)b * R * DM;
                    hipLaunchKernelGGL(nv::k_rmsnorm, dim3(R * 64 / 256), dim3(256), 0, stream, ob, norm_ffn, bufH, R);
                    ngemm<0>(stream, bufH, DM, ffn_g, DFF, big, DFF, R, DFF, DM);
                    ngemm<3>(stream, bufH, DM, ffn_u, DFF, big, DFF, R, DFF, DM);
                    ngemm<2>(stream, big, DFF, ffn_d, DM, ob, DM, R, DM, DFF, ob, DM);
                }
                launch(base + 13, base + 14);
            }
        } else {
            if (FAST_MOE) launch(base + 11, base + 16);
            else {
                for (int b = 0; b < 4; ++b) {
                    float* ob = out + (size_t)b * R * DM;
                    hipLaunchKernelGGL(nv::k_rmsnorm, dim3(R * 64 / 256), dim3(256), 0, stream, ob, norm_ffn + DM, bufH, R);
                    hipLaunchKernelGGL(nv::k_router, dim3(R * 64 / 256), dim3(256), 0, stream, bufH, moe_r, gate, R);
                    for (int e = 0; e < NE; ++e) {
                        ngemm<0>(stream, bufH, DM, moe_g + (size_t)e * DM * DFE, DFE, big, DFE, R, DFE, DM);
                        ngemm<3>(stream, bufH, DM, moe_u + (size_t)e * DM * DFE, DFE, big, DFE, R, DFE, DM);
                        ngemm<4>(stream, big, DFE, moe_d + (size_t)e * DFE * DM, DM, ob, DM, R, DM, DFE, gate + e, 8);
                    }
                }
            }
        }
    }
}
```

```cpp
#include <hip/hip_runtime.h>
#include <cstdio>
#include <cstdint>
#include <cmath>

#ifndef FAST_ATT
#define FAST_ATT 1
#endif
#ifndef FAST_MEM
#define FAST_MEM 1
#endif
#ifndef FAST_SSM
#define FAST_SSM 1
#endif
#ifndef FAST_FFN
#define FAST_FFN 1
#endif
#ifndef FAST_MOE
#define FAST_MOE 1
#endif
#ifndef PROBE_LO
#define PROBE_LO 0
#endif
#ifndef PROBE_HI
#define PROBE_HI 0
#endif
#ifndef PROBE_N
#define PROBE_N 1
#endif

namespace nv {
constexpr int SEQ = 4096, DM = 1024;
constexpr float EPS = 1e-6f;
__device__ __forceinline__ float wave_sum(float v) {
#pragma unroll
    for (int o = 1; o < 64; o <<= 1) v += __shfl_xor(v, o);
    return v;
}
__device__ __forceinline__ float wave_max(float v) {
#pragma unroll
    for (int o = 1; o < 64; o <<= 1) v = fmaxf(v, __shfl_xor(v, o));
    return v;
}
__device__ __forceinline__ float sigmoidf_(float x) { return 1.f / (1.f + __expf(-x)); }
__device__ __forceinline__ float gelu_tanh(float x) { const float u = 0.7978845608028654f * (x + 0.044715f * x * x * x); return 0.5f * x * (1.f + tanhf(u)); }

__global__ void __launch_bounds__(256) k_rmsnorm(const float* __restrict__ x, const float* __restrict__ g, float* __restrict__ y, int rows) {
    const int wave = (blockIdx.x * 256 + threadIdx.x) >> 6, lane = threadIdx.x & 63;
    if (wave >= rows) return;
    const float* xr = x + (size_t)wave * DM; float* yr = y + (size_t)wave * DM;
    float v[16]; float ss = 0.f;
#pragma unroll
    for (int j = 0; j < 16; ++j) { v[j] = xr[lane + 64 * j]; ss += v[j] * v[j]; }
    ss = wave_sum(ss);
    const float r = rsqrtf(ss * (1.f / DM) + EPS);
#pragma unroll
    for (int j = 0; j < 16; ++j) yr[lane + 64 * j] = v[j] * r * g[lane + 64 * j];
}
template <int MODE>
__global__ void __launch_bounds__(256) k_gemm(const float* __restrict__ A, int lda, const float* __restrict__ B, int ldb, float* C, int ldc, int K, const float* aux, int ldaux) {
    __shared__ float As[16][132];
    __shared__ float Bs[16][132];
    const int tid = threadIdx.x, tx = tid & 15, ty = tid >> 4;
    const int m0 = blockIdx.y * 128, n0 = blockIdx.x * 128;
    float acc[8][8];
#pragma unroll
    for (int i = 0; i < 8; ++i)
#pragma unroll
        for (int j = 0; j < 8; ++j) acc[i][j] = 0.f;
    for (int k0 = 0; k0 < K; k0 += 16) {
#pragma unroll
        for (int i = 0; i < 8; ++i) { const int e = tid + 256 * i, r = e >> 4, c = e & 15; As[c][r] = A[(size_t)(m0 + r) * lda + k0 + c]; }
#pragma unroll
        for (int i = 0; i < 8; ++i) { const int e = tid + 256 * i, r = e >> 7, c = e & 127; Bs[r][c] = B[(size_t)(k0 + r) * ldb + n0 + c]; }
        __syncthreads();
#pragma unroll
        for (int kk = 0; kk < 16; ++kk) {
            float a[8], b[8];
#pragma unroll
            for (int i = 0; i < 8; ++i) a[i] = As[kk][ty + 16 * i];
#pragma unroll
            for (int j = 0; j < 8; ++j) b[j] = Bs[kk][tx + 16 * j];
#pragma unroll
            for (int i = 0; i < 8; ++i)
#pragma unroll
                for (int j = 0; j < 8; ++j) acc[i][j] += a[i] * b[j];
        }
        __syncthreads();
    }
#pragma unroll
    for (int i = 0; i < 8; ++i)
#pragma unroll
        for (int j = 0; j < 8; ++j) {
            const int m = m0 + ty + 16 * i, n = n0 + tx + 16 * j; const size_t ci = (size_t)m * ldc + n; const float v = acc[i][j];
            if (MODE == 0) C[ci] = v;
            else if (MODE == 2) C[ci] = aux[(size_t)m * ldaux + n] + v;
            else if (MODE == 3) { const float gch = C[ci]; C[ci] = gch * sigmoidf_(gch) * v; }
            else if (MODE == 4) C[ci] = C[ci] + aux[(size_t)m * ldaux] * v;
        }
}
__global__ void __launch_bounds__(64) k_ssm(const float* __restrict__ U, float* __restrict__ Y, const float* a_re, const float* a_im, const float* log_dt, const float* b_re, const float* b_im,
                                            const float* c_re, const float* c_im, const float* dsk) {
    __shared__ float us[64][16];
    __shared__ float vs[16][65];
    __shared__ float ys[64][16];
    const int g = blockIdx.x, p = threadIdx.x;
    const float dt = expf(log_dt[g]);
    const float lr = a_re[g * 64 + p], li = a_im[g * 64 + p];
    const float mag = expf(lr * dt); float sn, cs; sincosf(li * dt, &sn, &cs);
    const float lbr = mag * cs, lbi = mag * sn;
    const float nr = lbr - 1.f, ni = lbi, den = lr * lr + li * li;
    const float fr = (nr * lr + ni * li) / den, fi = (ni * lr - nr * li) / den;
    float bbr[16], bbi[16], cr[16], ci[16];
#pragma unroll
    for (int c = 0; c < 16; ++c) {
        const float br = b_re[(g * 64 + p) * 16 + c], bi = b_im[(g * 64 + p) * 16 + c];
        bbr[c] = fr * br - fi * bi; bbi[c] = fr * bi + fi * br;
        cr[c] = c_re[(g * 16 + c) * 64 + p]; ci[c] = c_im[(g * 16 + c) * 64 + p];
    }
    const int cc = p & 15, qq = p >> 4;
    const float dskip = dsk[g * 16 + cc];
    float sr = 0.f, si = 0.f;
    for (int t0 = 0; t0 < SEQ; t0 += 64) {
        __syncthreads();
        { const float4* src = (const float4*)(U + (size_t)(t0 + p) * 512 + g * 16);
#pragma unroll
          for (int j = 0; j < 4; ++j) { const float4 v = src[j]; us[p][4 * j] = v.x; us[p][4 * j + 1] = v.y; us[p][4 * j + 2] = v.z; us[p][4 * j + 3] = v.w; } }
        __syncthreads();
        for (int t = 0; t < 64; ++t) {
            float bur = 0.f, bui = 0.f;
#pragma unroll
            for (int c = 0; c < 16; ++c) { const float u = us[t][c]; bur += bbr[c] * u; bui += bbi[c] * u; }
            const float nsr = lbr * sr - lbi * si + bur, nsi = lbr * si + lbi * sr + bui; sr = nsr; si = nsi;
#pragma unroll
            for (int c = 0; c < 16; ++c) vs[c][p] = cr[c] * sr - ci[c] * si;
            __syncthreads();
            float s = 0.f;
#pragma unroll
            for (int k = 0; k < 16; ++k) s += vs[cc][qq * 16 + k];
            s += __shfl_xor(s, 16); s += __shfl_xor(s, 32);
            if (qq == 0) ys[t][cc] = gelu_tanh(s + dskip * us[t][cc]);
            __syncthreads();
        }
        { float4* dst = (float4*)(Y + (size_t)(t0 + p) * 512 + g * 16);
#pragma unroll
          for (int j = 0; j < 4; ++j) dst[j] = make_float4(ys[p][4 * j], ys[p][4 * j + 1], ys[p][4 * j + 2], ys[p][4 * j + 3]); }
    }
}
__global__ void k_glu(const float* GA, float* S, int n) {
    const size_t i = (size_t)blockIdx.x * 256 + threadIdx.x; if (i >= (size_t)n) return;
    const size_t m = i >> 9; const int c = i & 511;
    S[i] = GA[m * 1024 + c] * sigmoidf_(GA[m * 1024 + 512 + c]);
}
template <int HD, bool ROPE>
__global__ void __launch_bounds__(256) k_headnorm(float* X, int ld, int col0, int nheads, int rows, const float* gain, const int* pos) {
    const int w = (blockIdx.x * 256 + threadIdx.x) >> 6, lane = threadIdx.x & 63;
    if (w >= rows * nheads) return;
    const int row = w / nheads, h = w % nheads;
    float* xp = X + (size_t)row * ld + col0 + h * HD;
    if (HD == 64) {
        const float x = xp[lane]; const float ss = wave_sum(x * x);
        float y = x * rsqrtf(ss * (1.f / 64) + EPS) * gain[lane];
        if (ROPE) {
            const float other = __shfl_xor(y, 32); const int j = lane & 31;
            const float inv = powf(10000.f, -(float)j / 32.f); const float ang = (float)pos[row] * inv;
            float sn, cs; sincosf(ang, &sn, &cs);
            y = (lane < 32) ? (y * cs - other * sn) : (other * sn + y * cs);
        }
        xp[lane] = y;
    } else {
        const float x0 = xp[lane], x1 = xp[lane + 64]; const float ss = wave_sum(x0 * x0 + x1 * x1);
        const float r = rsqrtf(ss * (1.f / 128) + EPS);
        xp[lane] = x0 * r * gain[lane]; xp[lane + 64] = x1 * r * gain[lane + 64];
    }
}
__global__ void __launch_bounds__(256) k_dilattn(const float* __restrict__ QKV, float* OG, float* LSE, int ntok) {
    const int w = (blockIdx.x * 256 + threadIdx.x) >> 6, lane = threadIdx.x & 63;
    if (w >= ntok * 12) return;
    const int h = w % 12, t = w / 12;
    const int g = h >> 2, slot = h & 3, d = (g == 0) ? 1 : (g == 1 ? 4 : 16);
    const int i = t / d, nk = (i < 128 ? i : 128) + 1;
    const float q = QKV[(size_t)t * 2304 + h * 64 + lane] * 0.125f;
    float s0 = -1e30f, s1 = -1e30f, s2 = -1e30f;
    for (int j = 0; j < nk; ++j) {
        const float k = QKV[(size_t)(t - j * d) * 2304 + 768 + h * 64 + lane];
        const float s = wave_sum(q * k);
        if (lane == (j & 63)) { if (j < 64) s0 = s; else if (j < 128) s1 = s; else s2 = s; }
    }
    const float m = wave_max(fmaxf(fmaxf(s0, s1), s2));
    const float p0 = (s0 > -1e29f) ? __expf(s0 - m) : 0.f, p1 = (s1 > -1e29f) ? __expf(s1 - m) : 0.f, p2 = (s2 > -1e29f) ? __expf(s2 - m) : 0.f;
    const float den = wave_sum(p0 + p1 + p2);
    float o = 0.f;
    for (int j = 0; j < nk; ++j) {
        const float pj = __shfl((j < 64) ? p0 : (j < 128 ? p1 : p2), j & 63);
        o += pj * QKV[(size_t)(t - j * d) * 2304 + 1536 + h * 64 + lane];
    }
    OG[((size_t)g * ntok + t) * 256 + slot * 64 + lane] = o / den;
    if (lane == 0) LSE[((size_t)g * ntok + t) * 4 + slot] = m + logf(den);
}
__global__ void k_attmerge(const float* OG, const float* LSE, float* AO, int ntok) {
    const size_t i = (size_t)blockIdx.x * 256 + threadIdx.x; if (i >= (size_t)ntok * 256) return;
    const size_t tok = i >> 8; const int c = i & 255, slot = c >> 6; const size_t N = ntok;
    const float l0 = LSE[(0 * N + tok) * 4 + slot], l1 = LSE[(1 * N + tok) * 4 + slot], l2 = LSE[(2 * N + tok) * 4 + slot];
    const float m = fmaxf(fmaxf(l0, l1), l2); const float e0 = __expf(l0 - m), e1 = __expf(l1 - m), e2 = __expf(l2 - m); const float inv = 1.f / (e0 + e1 + e2);
    AO[i] = (e0 * OG[(0 * N + tok) * 256 + c] + e1 * OG[(1 * N + tok) * 256 + c] + e2 * OG[(2 * N + tok) * 256 + c]) * inv;
}
__global__ void __launch_bounds__(256) k_memattn(const float* __restrict__ XQ, const float* __restrict__ KV, float* MO, int ntok) {
    const int w = (blockIdx.x * 256 + threadIdx.x) >> 6, lane = threadIdx.x & 63;
    if (w >= ntok * 4) return;
    const int h = w & 3, tok = w >> 2;
    const float sc = 0.08838834764831845f;
    const float q0 = XQ[(size_t)tok * 512 + h * 128 + lane] * sc, q1 = XQ[(size_t)tok * 512 + h * 128 + 64 + lane] * sc;
    float s[4] = {0.f, 0.f, 0.f, 0.f};
#pragma unroll
    for (int jj = 0; jj < 4; ++jj)
        for (int j = 0; j < 64; ++j) {
            const float* kr = KV + (size_t)(jj * 64 + j) * 1024 + h * 128;
            const float v = wave_sum(q0 * kr[lane] + q1 * kr[lane + 64]);
            if (lane == j) s[jj] = v;
        }
    const float m = wave_max(fmaxf(fmaxf(s[0], s[1]), fmaxf(s[2], s[3])));
    float p[4]; float ps = 0.f;
#pragma unroll
    for (int jj = 0; jj < 4; ++jj) { p[jj] = __expf(s[jj] - m); ps += p[jj]; }
    const float den = wave_sum(ps);
    float o0 = 0.f, o1 = 0.f;
#pragma unroll
    for (int jj = 0; jj < 4; ++jj)
        for (int j = 0; j < 64; ++j) {
            const float pj = __shfl(p[jj], j);
            const float* vr = KV + (size_t)(jj * 64 + j) * 1024 + 512 + h * 128;
            o0 += pj * vr[lane]; o1 += pj * vr[lane + 64];
        }
    MO[(size_t)tok * 512 + h * 128 + lane] = o0 / den; MO[(size_t)tok * 512 + h * 128 + 64 + lane] = o1 / den;
}
__global__ void __launch_bounds__(256) k_router(const float* __restrict__ H2, const float* __restrict__ Wr, float* gate, int rows) {
    const int w = (blockIdx.x * 256 + threadIdx.x) >> 6, lane = threadIdx.x & 63;
    if (w >= rows) return;
    float acc[8];
#pragma unroll
    for (int e = 0; e < 8; ++e) acc[e] = 0.f;
    for (int j = 0; j < 16; ++j) { const int k = lane + 64 * j; const float h = H2[(size_t)w * DM + k];
#pragma unroll
        for (int e = 0; e < 8; ++e) acc[e] += h * Wr[k * 8 + e]; }
#pragma unroll
    for (int e = 0; e < 8; ++e) acc[e] = wave_sum(acc[e]);
    int i0 = 0; float v0 = acc[0];
#pragma unroll
    for (int e = 1; e < 8; ++e) if (acc[e] > v0) { v0 = acc[e]; i0 = e; }
    int i1 = -1; float v1 = -3.4e38f;
#pragma unroll
    for (int e = 0; e < 8; ++e) if (e != i0 && acc[e] > v1) { v1 = acc[e]; i1 = e; }
    const float e1 = __expf(v1 - v0); const float w0 = 1.f / (1.f + e1), w1 = e1 / (1.f + e1);
    if (lane < 8) gate[(size_t)w * 8 + lane] = (lane == i0) ? w0 : ((lane == i1) ? w1 : 0.f);
}
__device__ __forceinline__ unsigned short f2bf_rne(float f) { unsigned u = __float_as_uint(f); return (unsigned short)((u + 0x7fffu + ((u >> 16) & 1u)) >> 16); }
__global__ void k_cvt_f2b(const float* src, unsigned short* dst, size_t n, int cols, int ldd) { const size_t i = (size_t)blockIdx.x * 256 + threadIdx.x; if (i < n) dst[(i / cols) * ldd + (i % cols)] = f2bf_rne(src[i]); }
}

namespace mk {
#define LAS __attribute__((address_space(3)))
#define GAS __attribute__((address_space(1)))
typedef unsigned short bf16_t;
typedef short bf16x8 __attribute__((ext_vector_type(8)));
typedef short s16x4 __attribute__((ext_vector_type(4)));
typedef float f32x4 __attribute__((ext_vector_type(4)));
typedef float f32x2 __attribute__((ext_vector_type(2)));
typedef unsigned u32x4 __attribute__((ext_vector_type(4)));
typedef unsigned u32x2 __attribute__((ext_vector_type(2)));
typedef __bf16 bf16x2_t __attribute__((ext_vector_type(2)));

constexpr int NB = 4, SEQ = 4096, DM = 1024, NT = NB * SEQ, INC = 6400;
constexpr int DFF = 2816, DFE = 3584, NE = 8;
constexpr float EPS = 1e-6f;
constexpr float LOG2E = 1.4426950408889634f, LN2 = 0.6931471805599453f;
constexpr int NWAVES = 8;

constexpr size_t MiB = (size_t)1 << 20;
constexpr size_t WS_CTL = 0, CTL_BYTES = 1 * MiB;
constexpr size_t WS_META = 1 * MiB;
constexpr size_t WS_ROPE = 2 * MiB;
constexpr size_t WS_SSMT = 6 * MiB;
constexpr size_t WS_WINP = 14 * MiB;
constexpr size_t WS_WL = 46 * MiB;
constexpr size_t WL_IN = 0, WL_GLU = 13 * MiB, WL_CAT = 14 * MiB  , WL_MKV = 17 * MiB, WL_WO = 19 * MiB;
constexpr size_t WL_STRIDE = 21 * MiB;
constexpr size_t WS_FFN = WS_WL + 2 * WL_STRIDE;
constexpr size_t WS_FFND = WS_FFN + 11 * MiB;
constexpr size_t WS_MEMN = 105 * MiB;
constexpr size_t WS_KVM = 109 * MiB;
constexpr size_t WS_SSMW = 113 * MiB;
constexpr size_t WS_A = 185 * MiB;
constexpr size_t WS_B = 217 * MiB;
constexpr size_t WS_C = 289 * MiB;
constexpr size_t WS_D = 305 * MiB;
constexpr size_t WS_E = 133 * MiB;
constexpr size_t WS_X8 = 153 * MiB;
constexpr size_t WS_F = 419 * MiB;
constexpr size_t WS_CAT = 444 * MiB;
constexpr size_t WS_SSQ = 484 * MiB;
constexpr size_t WS_XS = 485 * MiB;
constexpr size_t WS_NAIVE = WS_B;
constexpr size_t WS_END = 518 * MiB;
constexpr size_t WS_MOEW = 2 * MiB;
constexpr size_t WS_MOEWD = WS_MOEW + 112 * MiB;
constexpr size_t WS_MOEH = 170 * MiB;
constexpr size_t WS_MOEA = 408 * MiB;
static_assert(WS_X8 >= WS_E + 20 * MiB && WS_X8 + 16 * MiB <= WS_A && WL_WO + 2 * MiB <= WL_STRIDE && WS_FFND + 6 * MiB <= WS_MEMN && WS_MOEA + 68 * MiB <= WS_END && WS_MOEH + 238 * MiB <= WS_MOEA, "ws map");
constexpr size_t MT_NT = 0;
constexpr size_t MT_TEXP = 1024;
constexpr size_t MT_TOKE = 4096;
constexpr size_t MT_TOKW = MT_TOKE + 65536;
constexpr size_t MT_POS = MT_TOKW + 131072;
constexpr size_t MT_ROWW = MT_POS + 131072;
constexpr size_t MT_RSA = MT_ROWW + 34816 * 4;
constexpr size_t MT_SEXP = 2048;
constexpr size_t MT_SINV = 2048 + 128;
static_assert(MT_RSA + 34816 * 4 <= MiB, "meta");

constexpr int RING_BYTES = 131072, LDSCTL_OFF = RING_BYTES, LDS_BYTES = 147456;

__device__ __forceinline__ unsigned pk2(float lo, float hi) { f32x2 v = {lo, hi}; bf16x2_t b = __builtin_convertvector(v, bf16x2_t); return __builtin_bit_cast(unsigned, b); }
__device__ __forceinline__ float bflo(unsigned w) { return __uint_as_float(w << 16); }
__device__ __forceinline__ float bfhi(unsigned w) { return __uint_as_float(w & 0xffff0000u); }
__device__ __forceinline__ float fsigmoid(float x) { return __builtin_amdgcn_rcpf(1.f + __builtin_amdgcn_exp2f(-x * LOG2E)); }
__device__ __forceinline__ float fgelu(float x) { return x * fsigmoid(1.5957691216057308f * (x + 0.044715f * x * x * x)); }
__device__ __forceinline__ int lane_id_l() { int l = (int)__builtin_amdgcn_mbcnt_hi(~0u, __builtin_amdgcn_mbcnt_lo(~0u, 0u)); asm volatile("" : "+v"(l)); return l; }
__device__ __forceinline__ float shx(float v, int m, int lane) { return __int_as_float(__builtin_amdgcn_ds_bpermute((lane ^ m) << 2, __float_as_int(v))); }
typedef unsigned u2v __attribute__((ext_vector_type(2)));
__device__ __forceinline__ float xsum4(float x) {
    const unsigned xi = __float_as_uint(x); const u2v r = __builtin_amdgcn_permlane16_swap(xi, xi, false, false); const float s = __uint_as_float(r.x) + __uint_as_float(r.y);
    const unsigned si = __float_as_uint(s); const u2v q = __builtin_amdgcn_permlane32_swap(si, si, false, false); return __uint_as_float(q.x) + __uint_as_float(q.y); }
__device__ __forceinline__ float xmax4(float x) {
    const unsigned xi = __float_as_uint(x); const u2v r = __builtin_amdgcn_permlane16_swap(xi, xi, false, false); const float s = fmaxf(__uint_as_float(r.x), __uint_as_float(r.y));
    const unsigned si = __float_as_uint(s); const u2v q = __builtin_amdgcn_permlane32_swap(si, si, false, false); return fmaxf(__uint_as_float(q.x), __uint_as_float(q.y)); }
__device__ __forceinline__ float shi(float v, int src, int) { return __int_as_float(__builtin_amdgcn_ds_bpermute(src << 2, __float_as_int(v))); }
template <int CTRL> __device__ __forceinline__ float dppf(float v) { return __int_as_float(__builtin_amdgcn_update_dpp(0, __float_as_int(v), CTRL, 0xF, 0xF, false)); }
__device__ __forceinline__ float rowsum16(float v) { v += dppf<0x121>(v); v += dppf<0x122>(v); v += dppf<0x124>(v); v += dppf<0x128>(v); return v; }
__device__ __forceinline__ float wave_sum(float v, int lane) { (void)lane; return xsum4(rowsum16(v)); }
#define INF(k) lds_ptr<const float>(lds, (k))
#define LDS_WAIT() asm volatile("s_waitcnt lgkmcnt(0)" ::: "memory")
#define VM_WAIT() asm volatile("s_waitcnt vmcnt(0)" ::: "memory")

constexpr int BM = 256, BK = 64, HALF = 128, HTB = HALF * BK * 2, NXCD = 8, WGM = 8;
__device__ __forceinline__ int lds_byte(int r, int c) { const int st = (r >> 4) * 2 + (c >> 5), rr = r & 15, cc = c & 31, ob = rr * 64 + cc * 2; return st * 1024 + (ob ^ (((ob >> 9) & 1) << 5)); }
__device__ __forceinline__ void stage_rc(int b, int& R, int& C) { const int st = b / 1024, sb = b % 1024, swz = sb ^ (((sb >> 9) & 1) << 5); R = (st >> 1) * 16 + swz / 64; C = (st & 1) * 32 + (swz % 64) / 2; }
__device__ __forceinline__ int perm32(int rho) { const int n = rho >> 4, i = rho & 15; return 8 * (i >> 2) + 4 * n + (i & 3); }

__device__ __forceinline__ int lds_byte_b(int r, int bc) { const int st = (r >> 4) * 2 + (bc >> 6), rr = r & 15, ob = rr * 64 + (bc & 63); return st * 1024 + (ob ^ (((ob >> 9) & 1) << 5)); }
typedef int v8i32 __attribute__((ext_vector_type(8)));
typedef float v8f32 __attribute__((ext_vector_type(8)));
__device__ __forceinline__ unsigned pk4_fp8(float a, float b, float c, float d) { int w = 0; w = __builtin_amdgcn_cvt_pk_fp8_f32(a, b, w, false); w = __builtin_amdgcn_cvt_pk_fp8_f32(c, d, w, true); return (unsigned)w; }
__device__ __forceinline__ float clamp448(float x) { return fminf(fmaxf(x, -448.f), 448.f); }
constexpr int LDSPTR_OFF = LDSCTL_OFF + 512;
template <typename T> __device__ __forceinline__ T* lds_ptr(LAS unsigned char* lds, int k) {
    unsigned off = LDSPTR_OFF + 8 * k; asm volatile("" : "+v"(off));
    const unsigned lo = *(volatile LAS unsigned*)(lds + off), hi = *(volatile LAS unsigned*)(lds + off + 4);
    typedef __attribute__((address_space(1))) T GT;
    return (T*)(GT*)(((unsigned long long)(unsigned)__builtin_amdgcn_readfirstlane((int)hi) << 32) | (unsigned long long)(unsigned)__builtin_amdgcn_readfirstlane((int)lo));
}
__device__ __forceinline__ unsigned gate_code(float z) { const float v = 1.f + __builtin_amdgcn_exp2f(-z * LOG2E); const float l = fminf(32.f * __builtin_amdgcn_logf(v) + 0.5f, 255.f); return (unsigned)l; }
__device__ __forceinline__ float ub(unsigned w, int i) { return (float)((w >> (8 * i)) & 255u); }
struct Unit { int pm, pn, pb, k0, nt, q; };
struct Gemm { const bf16_t* A; const bf16_t* Bt; int lda, ldb, K; };
struct Sched {
    int mode, nM, nN, nwg, G, c, pn0, nfull; const int* texp; LAS const int* texl;
    __device__ __forceinline__ bool next(int i, Unit& u) const {
        const long L = (long)i * G + c; if (L >= nwg) return false;
        u.k0 = 0; u.nt = 0; u.q = 0;
        if (mode == 1) { u.pm = (int)L / nN; u.pn = (int)L % nN; u.pb = u.pm * nN + u.pn; return true; }
        if (mode == 5) { u.pm = (int)L / nN; u.pn = (int)L % nN; u.pb = (u.pm >> 1) * nN + u.pn; return true; }
        if (mode == 4 && L >= (long)nfull * nN) { const int j = (int)L - nfull * nN; u.pm = nfull + (j >> 4); u.pn = (j >> 2) & 3; u.q = j & 3; u.k0 = (u.q < 2) ? 1024 * u.q : 2048 + 768 * (u.q - 2); u.nt = (u.q < 2) ? 8 : 6;
            u.pb = __builtin_amdgcn_readfirstlane(texl[u.pm]) * nN + u.pn; return true; }
        if (mode == 3) { u.pm = (int)L / nN; u.pn = (int)L % nN; u.pb = (u.pm >> 2) * (int)(WL_STRIDE / (512 * 1024)) + u.pn; return true; }
        const int nwg_ = (mode == 4) ? nfull * nN : nwg;
        int wgid = (int)L; { const int q = nwg_ / NXCD, r = nwg_ % NXCD, xcd = wgid % NXCD, off = wgid / NXCD; wgid = (xcd < r ? xcd * (q + 1) : r * (q + 1) + (xcd - r) * q) + off; }
        const int nM_ = (mode == 4) ? nfull : nM;
        const int nig = WGM * nN, gid = wgid / nig, fm = gid * WGM, gsz = (nM_ - fm) < WGM ? (nM_ - fm) : WGM;
        u.pm = fm + ((wgid % nig) % gsz); u.pn = (wgid % nig) / gsz + pn0; u.pb = u.pn;
        if (mode == 2 || mode == 4) u.pb = __builtin_amdgcn_readfirstlane(texl[u.pm]) * nN + u.pn;
        return true;
    }
};
enum { EP_INPROJ = 0, EP_BF16, EP_GLU, EP_SWIGLU, EP_SWIGLUQ, EP_MERGEF, EP_RESID, EP_SSMOUT, EP_ZSCAN, EP_MOEDOWN, EP_MOEDOWNQ, EP_GATEQ };
struct Epi {
    int mode, perm, after_drain;
    bf16_t* o0; bf16_t* o1; bf16_t* o2; bf16_t* o3; int ldo;
    const bf16_t* gt;
    float* fo; const float* fr;
    const float* ptab;
    unsigned char* x8;
    bf16_t* xb; float* ssq; const float* ssqr;

    __device__ __forceinline__ void rows_rstd(float (&rs)[2][4], int row0, int fq, int lane_, float base) const {
        if (ssqr) { f32x4 p[2][4];
#pragma unroll
            for (int ai = 0; ai < 2; ++ai)
#pragma unroll
                for (int m = 0; m < 4; ++m) p[ai][m] = *(const f32x4*)(ssqr + (size_t)(row0 + ai * HALF + m * 16) * 16 + 4 * fq);
#pragma unroll
            for (int ai = 0; ai < 2; ++ai)
#pragma unroll
                for (int m = 0; m < 4; ++m) { float sq = (p[ai][m].x + p[ai][m].y) + (p[ai][m].z + p[ai][m].w); sq = xsum4(sq); rs[ai][m] = base / sqrtf(sq * (1.f / DM) + EPS); }
        } else {
#pragma unroll
            for (int ai = 0; ai < 2; ++ai)
#pragma unroll
                for (int m = 0; m < 4; ++m) rs[ai][m] = base; }
    }
    __device__ __forceinline__ void run_qk(const f32x4 (&acc)[2][2][4][2], const Unit& u, int wr, int wc, int fr_, int fq, LAS unsigned char* lds, const bool scaled) const {
        const int row0 = u.pm * BM + wr * 64 + fr_, lane_ = fq * 16 + fr_;
        const bool isq = u.pn < 5;
        const int lay = __builtin_amdgcn_readfirstlane(*(volatile LAS int*)(lds + LDSCTL_OFF + 256 + 4 * (wr * 4 + wc)));
        const float* gp = lds_ptr<const float>(lds, isq ? 15 : 16) + lay * 64 + 8 * fq;
        const float* rope = (const float*)(lds_ptr<const unsigned char>(lds, 33) + WS_ROPE);
        const f32x4 g00 = *(const f32x4*)gp, g01 = *(const f32x4*)(gp + 4), g10 = *(const f32x4*)(gp + 32), g11 = *(const f32x4*)(gp + 36);
        const float qs = isq ? 0.125f * LOG2E : 1.0f;
        float insc = 1.f; if (scaled) insc = ((const float*)(lds_ptr<const unsigned char>(lds, 33) + WS_META + MT_SINV))[27 + lay] * 0.0625f;
        float rs8[2][4]; rows_rstd(rs8, row0, fq, lane_, insc);
#pragma unroll
        for (int ai2 = 0; ai2 < 4; ++ai2) { const int ai = ai2 >> 1;
            f32x4 tq[4][4];
#pragma unroll
            for (int m = 2 * (ai2 & 1); m < 2 * (ai2 & 1) + 2; ++m) { const f32x4* rp = (const f32x4*)(rope + (size_t)(row0 + ai * HALF + m * 16) * 64 + 16 * fq);
#pragma unroll
                for (int j = 0; j < 4; ++j) tq[m][j] = rp[j]; }
            __builtin_amdgcn_sched_barrier(0);
#pragma unroll
            for (int m = 2 * (ai2 & 1); m < 2 * (ai2 & 1) + 2; ++m) { const int row = row0 + ai * HALF + m * 16; const float rstd = rs8[ai][m];
                f32x4 a0 = acc[ai][0][m][0] * rstd, a1 = acc[ai][0][m][1] * rstd, b0 = acc[ai][1][m][0] * rstd, b1 = acc[ai][1][m][1] * rstd;
                float ss = (a0.x * a0.x + a0.y * a0.y) + (a0.z * a0.z + a0.w * a0.w) + (a1.x * a1.x + a1.y * a1.y) + (a1.z * a1.z + a1.w * a1.w)
                         + (b0.x * b0.x + b0.y * b0.y) + (b0.z * b0.z + b0.w * b0.w) + (b1.x * b1.x + b1.y * b1.y) + (b1.z * b1.z + b1.w * b1.w);
                ss = xsum4(ss);
                const float r = qs / sqrtf(ss * (1.f / 64.f) + EPS);
                a0 = a0 * r * g00; a1 = a1 * r * g01; b0 = b0 * r * g10; b1 = b1 * r * g11;
                const f32x4 t0 = tq[m][0], t1 = tq[m][1], t2 = tq[m][2], t3 = tq[m][3];
                f32x4 o00, o01, o10, o11;
                o00.x = a0.x * t0.x - b0.x * t0.y; o10.x = a0.x * t0.y + b0.x * t0.x; o00.y = a0.y * t0.z - b0.y * t0.w; o10.y = a0.y * t0.w + b0.y * t0.z;
                o00.z = a0.z * t1.x - b0.z * t1.y; o10.z = a0.z * t1.y + b0.z * t1.x; o00.w = a0.w * t1.z - b0.w * t1.w; o10.w = a0.w * t1.w + b0.w * t1.z;
                o01.x = a1.x * t2.x - b1.x * t2.y; o11.x = a1.x * t2.y + b1.x * t2.x; o01.y = a1.y * t2.z - b1.y * t2.w; o11.y = a1.y * t2.w + b1.y * t2.z;
                o01.z = a1.z * t3.x - b1.z * t3.y; o11.z = a1.z * t3.y + b1.z * t3.x; o01.w = a1.w * t3.z - b1.w * t3.w; o11.w = a1.w * t3.w + b1.w * t3.z;
                bf16_t* dst = o1 + (size_t)row * 2304 + (u.pn * BM - 512) + 64 * wc + 8 * fq;
                u32x4 w; w.x = pk2(o00.x, o00.y); w.y = pk2(o00.z, o00.w); w.z = pk2(o01.x, o01.y); w.w = pk2(o01.z, o01.w); *(u32x4*)dst = w;
                w.x = pk2(o10.x, o10.y); w.y = pk2(o10.z, o10.w); w.z = pk2(o11.x, o11.y); w.w = pk2(o11.z, o11.w); *(u32x4*)(dst + 32) = w; }
            __builtin_amdgcn_sched_barrier(0); }
    }
    template <bool FP8> __device__ __forceinline__ void run(const f32x4 (&acc)[2][2][4][2], const Unit& u, int wr, int wc, int fr_, int fq, LAS unsigned char* lds) const {
        if (mode == EP_INPROJ && u.pn >= 2 && u.pn < 8) { run_qk(acc, u, wr, wc, fr_, fq, lds, FP8); return; }
        const int row0 = u.pm * BM + wr * 64 + fr_;
        const unsigned char* wsm = lds_ptr<const unsigned char>(lds, 33) + WS_META;
        const float* roww = (const float*)(wsm + MT_ROWW); const float* rsa = (const float*)(wsm + MT_RSA); const float* sinv = (const float*)(wsm + MT_SINV); const int* sexp = (const int*)(wsm + MT_SEXP);
        if (mode == EP_RESID) {
            const int lane_ = fq * 16 + fr_; const float asc = FP8 ? sinv[29] * 0.0625f : 1.f;
#define RESID_BODY(HASF_, HASX8_) \
            _Pragma("unroll") for (int ai = 0; ai < 2; ++ai) { \
                f32x4 xr[4][2][2]; \
                _Pragma("unroll") for (int m = 0; m < 4; ++m) _Pragma("unroll") for (int bj = 0; bj < 2; ++bj) { const size_t off = (size_t)(row0 + ai * HALF + m * 16) * DM + u.pn * BM + bj * HALF + wc * 32 + 8 * fq; \
                    if (HASF_) { xr[m][bj][0] = __builtin_nontemporal_load((const f32x4*)(fr + off)); xr[m][bj][1] = __builtin_nontemporal_load((const f32x4*)(fr + off + 4)); } \
                    else { const u32x4 rv = *(const u32x4*)(xb + off); xr[m][bj][0] = (f32x4){bflo(rv.x), bfhi(rv.x), bflo(rv.y), bfhi(rv.y)}; xr[m][bj][1] = (f32x4){bflo(rv.z), bfhi(rv.z), bflo(rv.w), bfhi(rv.w)}; } } \
                _Pragma("unroll") for (int m = 0; m < 4; ++m) { const int row = row0 + ai * HALF + m * 16; float ss = 0.f; \
                    _Pragma("unroll") for (int bj = 0; bj < 2; ++bj) { const size_t off = (size_t)row * DM + u.pn * BM + bj * HALF + wc * 32 + 8 * fq; \
                        const f32x4 x0 = xr[m][bj][0] + acc[ai][bj][m][0] * asc, x1 = xr[m][bj][1] + acc[ai][bj][m][1] * asc; \
                        u32x4 w; w.x = pk2(x0.x, x0.y); w.y = pk2(x0.z, x0.w); w.z = pk2(x1.x, x1.y); w.w = pk2(x1.z, x1.w); *(u32x4*)(xb + off) = w; \
                        if (HASX8_) { u32x2 q; q.x = pk4_fp8(clamp448(16.f * x0.x), clamp448(16.f * x0.y), clamp448(16.f * x0.z), clamp448(16.f * x0.w)); q.y = pk4_fp8(clamp448(16.f * x1.x), clamp448(16.f * x1.y), clamp448(16.f * x1.z), clamp448(16.f * x1.w)); *(u32x2*)(x8 + off) = q; } \
                        ss += (x0.x * x0.x + x0.y * x0.y) + (x0.z * x0.z + x0.w * x0.w) + (x1.x * x1.x + x1.y * x1.y) + (x1.z * x1.z + x1.w * x1.w); } \
                    ss = xsum4(ss); if (fq == 0) ssq[(size_t)row * 16 + u.pn * 4 + wc] = ss; } }
            if (fr) { RESID_BODY(true, false) }
            else if (x8) { RESID_BODY(false, true) }
            else { RESID_BODY(false, false) }
#undef RESID_BODY
            return;
        }
        if (FP8 && mode == EP_GATEQ) {
            const int lay = __builtin_amdgcn_readfirstlane(*(volatile LAS int*)(lds + LDSCTL_OFF + 256 + 4 * (wr * 4 + wc)));
            const float sc = sinv[27 + lay] * 0.0625f; const int lane_ = fq * 16 + fr_;
            float rs8[2][4]; rows_rstd(rs8, row0, fq, lane_, sc);
#pragma unroll
            for (int ai = 0; ai < 2; ++ai)
#pragma unroll
                for (int m = 0; m < 4; ++m) { const int row = row0 + ai * HALF + m * 16; const float rs = rs8[ai][m];
#pragma unroll
                    for (int bj = 0; bj < 2; ++bj) { const int col = u.pn * BM + bj * HALF + wc * 32 + 8 * fq; float v[8];
#pragma unroll
                        for (int e = 0; e < 4; ++e) { v[e] = acc[ai][bj][m][0][e] * rs; v[4 + e] = acc[ai][bj][m][1][e] * rs; }
                        unsigned c8[8];
#pragma unroll
                        for (int e = 0; e < 8; ++e) c8[e] = gate_code(v[e]);
                        u32x2 w; w.x = c8[0] | (c8[1] << 8) | (c8[2] << 16) | (c8[3] << 24); w.y = c8[4] | (c8[5] << 8) | (c8[6] << 16) | (c8[7] << 24); *(u32x2*)((unsigned char*)o3 + (size_t)row * 3072 + col) = w; } }
            return;
        }
        if (FP8 && mode == EP_INPROJ) {
            const int lay = __builtin_amdgcn_readfirstlane(*(volatile LAS int*)(lds + LDSCTL_OFF + 256 + 4 * (wr * 4 + wc)));
            const float sc = sinv[27 + lay] * 0.0625f; const int lane_ = fq * 16 + fr_;
            float rs8[2][4]; rows_rstd(rs8, row0, fq, lane_, sc);
#pragma unroll
            for (int ai = 0; ai < 2; ++ai)
#pragma unroll
                for (int m = 0; m < 4; ++m) { const int row = row0 + ai * HALF + m * 16; const float rs = rs8[ai][m];
#pragma unroll
                    for (int bj = 0; bj < 2; ++bj) { const int col = u.pn * BM + bj * HALF + wc * 32 + 8 * fq; bf16_t* dst;
                        if (col < 512) { const int g = col >> 4, cp = col & 15, b = row >> 12, t = row & 4095, k = t >> 5, s_ = t & 31; dst = o0 + ((size_t)(g * 512 + b * 128 + k)) * 640 + s_ * 16 + cp; }
                        else if (col < 2816) dst = o1 + (size_t)row * 2304 + (col - 512);
                        else dst = o2 + (size_t)row * 512 + (col - 2816);
                        u32x4 w; w.x = pk2(acc[ai][bj][m][0][0] * rs, acc[ai][bj][m][0][1] * rs); w.y = pk2(acc[ai][bj][m][0][2] * rs, acc[ai][bj][m][0][3] * rs);
                        w.z = pk2(acc[ai][bj][m][1][0] * rs, acc[ai][bj][m][1][1] * rs); w.w = pk2(acc[ai][bj][m][1][2] * rs, acc[ai][bj][m][1][3] * rs); *(u32x4*)dst = w; } }
            return;
        }
        if (FP8 && mode == EP_MOEDOWNQ) {
            const int ex = u.pb >> 2; const float sc = sinv[16 + ex] * __builtin_amdgcn_exp2f((float)(13 - sexp[2 * ex] - sexp[2 * ex + 1]));
            float rw8[2][4];
#pragma unroll
            for (int ai = 0; ai < 2; ++ai)
#pragma unroll
                for (int m = 0; m < 4; ++m) rw8[ai][m] = roww[row0 + ai * HALF + m * 16];
            __builtin_amdgcn_sched_barrier(0);
#pragma unroll
            for (int ai = 0; ai < 2; ++ai)
#pragma unroll
                for (int m = 0; m < 4; ++m) { const int row = row0 + ai * HALF + m * 16; const float w = rw8[ai][m] * sc;
#pragma unroll
                    for (int bj = 0; bj < 2; ++bj) { const int col = u.pn * BM + bj * HALF + wc * 32 + 8 * fq; u32x4 o;
                        o.x = pk2(acc[ai][bj][m][0][0] * w, acc[ai][bj][m][0][1] * w); o.y = pk2(acc[ai][bj][m][0][2] * w, acc[ai][bj][m][0][3] * w);
                        o.z = pk2(acc[ai][bj][m][1][0] * w, acc[ai][bj][m][1][1] * w); o.w = pk2(acc[ai][bj][m][1][2] * w, acc[ai][bj][m][1][3] * w);
                        bf16_t* dp = (u.q == 0) ? o0 + (size_t)row * DM + col : o1 + ((size_t)(u.q - 1) * 2048 + (row - 32768)) * DM + col;
                        *(u32x4*)dp = o; } }
            return;
        }
        if (FP8 || mode == EP_GLU || mode == EP_SWIGLU) {
            const int col0 = u.pn * HALF + wc * 32 + 8 * fq;
            float sg = 1.f, su = 1.f, hs = 1.f; if (FP8) { const int ex = u.pb / 28; sg = sinv[2 * ex] * 0.0625f; su = sinv[2 * ex + 1] * 0.0625f; hs = __builtin_amdgcn_exp2f((float)(sexp[2 * ex] + sexp[2 * ex + 1] - 13)); }
            float rs8[2][4];
            if constexpr (FP8) {
#pragma unroll
                for (int ai = 0; ai < 2; ++ai)
#pragma unroll
                    for (int m = 0; m < 4; ++m) rs8[ai][m] = 1.f;
            } else rows_rstd(rs8, row0, fq, fq * 16 + fr_, 1.f);
            const bool glu = !FP8 && mode == EP_GLU;
            if (glu) {
#pragma unroll
                for (int ai = 0; ai < 2; ++ai)
#pragma unroll
                    for (int m = 0; m < 4; ++m) { const int row = row0 + ai * HALF + m * 16; float v[8]; const float ra = rs8[ai][m];
#pragma unroll
                        for (int n = 0; n < 2; ++n)
#pragma unroll
                            for (int e = 0; e < 4; ++e) { const float a = acc[ai][0][m][n][e] * ra, b = acc[ai][1][m][n][e] * ra; v[4 * n + e] = a * fsigmoid(b); }
                        if (x8) {
                            u32x2 w; w.x = pk4_fp8(clamp448(16.f * v[0]), clamp448(16.f * v[1]), clamp448(16.f * v[2]), clamp448(16.f * v[3])); w.y = pk4_fp8(clamp448(16.f * v[4]), clamp448(16.f * v[5]), clamp448(16.f * v[6]), clamp448(16.f * v[7])); *(u32x2*)(x8 + (size_t)row * ldo + col0) = w;
                        } else { u32x4 w; w.x = pk2(v[0], v[1]); w.y = pk2(v[2], v[3]); w.z = pk2(v[4], v[5]); w.w = pk2(v[6], v[7]); *(u32x4*)(o0 + (size_t)row * ldo + col0) = w; } }
            } else {
#pragma unroll
                for (int ai = 0; ai < 2; ++ai)
#pragma unroll
                    for (int m = 0; m < 4; ++m) { const int row = row0 + ai * HALF + m * 16; float v[8]; const float ra = sg * rs8[ai][m], rb = su * rs8[ai][m];
                        const float kk = ra * rb * (FP8 ? hs : 1.f), rneg = -LOG2E * ra;
#pragma unroll
                        for (int n = 0; n < 2; ++n)
#pragma unroll
                            for (int e = 0; e < 4; ++e) {
                                const float ag = acc[ai][0][m][n][e], au = acc[ai][1][m][n][e];
                                v[4 * n + e] = (ag * au) * (kk * __builtin_amdgcn_rcpf(1.f + __builtin_amdgcn_exp2f(ag * rneg))); }
                        if (FP8) {
#pragma unroll
                            for (int e = 0; e < 8; ++e) v[e] = __builtin_amdgcn_fmed3f(v[e], -448.f, 448.f);
                            u32x2 w; w.x = pk4_fp8(v[0], v[1], v[2], v[3]); w.y = pk4_fp8(v[4], v[5], v[6], v[7]); *(u32x2*)((unsigned char*)o0 + (size_t)row * ldo + col0) = w;
                        } else { u32x4 w; w.x = pk2(v[0], v[1]); w.y = pk2(v[2], v[3]); w.z = pk2(v[4], v[5]); w.w = pk2(v[6], v[7]); *(u32x4*)(o0 + (size_t)row * ldo + col0) = w; } }
            }
            return;
        }
        if (!FP8 && mode == EP_MERGEF) {
            u32x2 gv[2][4][2];
#pragma unroll
            for (int ai = 0; ai < 2; ++ai)
#pragma unroll
                for (int m = 0; m < 4; ++m)
#pragma unroll
                    for (int bj = 0; bj < 2; ++bj) gv[ai][m][bj] = *(const u32x2*)((const unsigned char*)gt + 2048 + (size_t)(row0 + ai * HALF + m * 16) * 3072 + u.pn * BM + bj * HALF + wc * 32 + 8 * fq);
#pragma unroll
            for (int ai = 0; ai < 2; ++ai)
#pragma unroll
                for (int m = 0; m < 4; ++m)
#pragma unroll
                    for (int bj = 0; bj < 2; ++bj) { const int row = row0 + ai * HALF + m * 16, col = u.pn * BM + bj * HALF + wc * 32 + 8 * fq; float v[8];
#pragma unroll
                        for (int e = 0; e < 4; ++e) { v[e] = acc[ai][bj][m][0][e] * __builtin_amdgcn_exp2f(ub(gv[ai][m][bj].x, e) * -0.03125f); v[4 + e] = acc[ai][bj][m][1][e] * __builtin_amdgcn_exp2f(ub(gv[ai][m][bj].y, e) * -0.03125f); }
                        if (x8) {
                            u32x2 q; q.x = pk4_fp8(clamp448(16.f * v[0]), clamp448(16.f * v[1]), clamp448(16.f * v[2]), clamp448(16.f * v[3])); q.y = pk4_fp8(clamp448(16.f * v[4]), clamp448(16.f * v[5]), clamp448(16.f * v[6]), clamp448(16.f * v[7]));
                            *(u32x2*)(x8 + (size_t)row * DM + col) = q;
                        } else { u32x4 w; w.x = pk2(v[0], v[1]); w.y = pk2(v[2], v[3]); w.z = pk2(v[4], v[5]); w.w = pk2(v[6], v[7]); *(u32x4*)(o0 + (size_t)row * DM + col) = w; } }
            return;
        }
        if constexpr (!FP8) {
        float rs8[2][4]; if (mode == EP_INPROJ) rows_rstd(rs8, row0, fq, fq * 16 + fr_, 1.f);
#pragma unroll
        for (int ai = 0; ai < 2; ++ai)
#pragma unroll
            for (int m = 0; m < 4; ++m) { const int row = row0 + ai * HALF + m * 16; const float rstd = (mode == EP_INPROJ) ? rs8[ai][m] : 1.f;
#pragma unroll
                for (int bj = 0; bj < 2; ++bj) {
                    const int col = u.pn * BM + bj * HALF + wc * 32 + 8 * fq;
                    float v[8];
#pragma unroll
                    for (int e = 0; e < 4; ++e) { v[e] = acc[ai][bj][m][0][e]; v[4 + e] = acc[ai][bj][m][1][e]; }
                    bf16_t* dst;
                    if (mode == EP_INPROJ) {
#pragma unroll
                        for (int e = 0; e < 8; ++e) v[e] *= rstd;
                        if (col < 512) { const int g = col >> 4, cp = col & 15, b = row >> 12, t = row & 4095, k = t >> 5, s = t & 31; dst = o0 + ((size_t)(g * 512 + b * 128 + k)) * 640 + s * 16 + cp; }
                        else if (col < 2816) dst = o1 + (size_t)row * 2304 + (col - 512);
                        else if (col < 3328) dst = o2 + (size_t)row * 512 + (col - 2816);
                        else { dst = o3 + (size_t)row * 3072 + (col - 3328); }
                    } else if (mode == EP_BF16) { dst = o0 + (size_t)row * ldo + col;
                    } else if (mode == EP_SSMOUT) {
                        const int g = u.pm >> 1, rg = row & 511, b = rg >> 7, k = rg & 127, t = col >> 4, c = col & 15;
                        dst = o0 + ((size_t)(b * 4096 + k * 32 + t)) * 512 + g * 16 + c;
#pragma unroll
                        for (int e = 0; e < 8; ++e) v[e] = fgelu(v[e]);
                    } else {
                        dst = o0 + (size_t)row * DM + col; const float w = roww[row];
#pragma unroll
                        for (int e = 0; e < 8; ++e) v[e] *= w;
                    }
                    u32x4 w; w.x = pk2(v[0], v[1]); w.y = pk2(v[2], v[3]); w.z = pk2(v[4], v[5]); w.w = pk2(v[6], v[7]); *(u32x4*)dst = w;
                } }
        }
    }
    __device__ __forceinline__ void fused(const f32x4 (&acc)[2][2][4][2], const Unit& u, int wr, int wc, int fr_, int fq, LAS unsigned char* lds, int tid) const {
        LAS float* Zs = (LAS float*)lds;
#pragma unroll
        for (int ai = 0; ai < 2; ++ai)
#pragma unroll
            for (int m = 0; m < 4; ++m)
#pragma unroll
                for (int n = 0; n < 2; ++n) { const int row = ai * HALF + wr * 64 + m * 16 + fr_, col = wc * 32 + n * 16 + 4 * fq; *(LAS f32x4*)(Zs + row * 128 + col) = acc[ai][0][m][n]; }
        LDS_WAIT(); __builtin_amdgcn_s_barrier(); asm volatile("" ::: "memory");
        if (tid < 128) {
            const int bb = tid >> 6, p = tid & 63, g = u.pm >> 1;
            const f32x2 lt = *(const f32x2*)(ptab + ((size_t)(g * 33 + 32) * 64 + p) * 2);
            float sr = 0.f, si = 0.f;
            bf16_t* dst = o0 + ((size_t)(u.pm * 256 + bb * 128)) * 640 + 512 + 2 * p;
            for (int k = 0; k < 128; ++k) {
                *(unsigned*)(dst + (size_t)k * 640) = pk2(sr, si);
                const float zr = Zs[(bb * 128 + k) * 128 + 2 * p], zi = Zs[(bb * 128 + k) * 128 + 2 * p + 1];
                const float nr = lt.x * sr - lt.y * si + zr, ni = lt.x * si + lt.y * sr + zi; sr = nr; si = ni;
            }
        }
        LDS_WAIT(); __builtin_amdgcn_s_barrier(); asm volatile("" ::: "memory");
    }
};

template <bool FP8>
__device__ __forceinline__ void gemm_phase(LAS unsigned char* lds, const int wid, const Gemm g, const Sched& S, const Epi& E) {
    constexpr int ESZ = FP8 ? 1 : 2, BKE = FP8 ? 128 : 64;
    const int lane = lane_id_l(), tid = wid * 64 + lane, wr = wid >> 2, wc = wid & 3, fr = lane & 15, fq = lane >> 4;
    const int K = g.K, nt = K / BKE;
    unsigned voffA, voffB;
    { int R, C; stage_rc(tid * 16, R, C); const int Rb = E.perm ? ((R & ~31) + perm32(R & 31)) : R;
        voffA = (unsigned)(R * g.lda * ESZ + C * 2); voffB = (unsigned)(Rb * g.ldb * ESZ + C * 2); }
    const size_t p2A = (size_t)64 * g.lda * ESZ, p2B = (size_t)64 * g.ldb * ESZ;
    const size_t kstep = (size_t)(BK * 2);
    const size_t hstepA = (size_t)HALF * g.lda * ESZ, hstepB = (size_t)HALF * g.ldb * ESZ, tstepA = 2 * hstepA, tstepB = 2 * hstepB;
    const unsigned ldsw = (unsigned)wid * 1024u;
    const int aoff = FP8 ? lds_byte_b(wr * 64 + fr, fq * 32) : lds_byte(wr * 64 + fr, fq * 8), boff = FP8 ? lds_byte_b(wc * 32 + fr, fq * 32) : lds_byte(wc * 32 + fr, fq * 8);
#define PG8_SA(b, h) (((b) * 2 + (h)) * HTB)
#define PG8_SB(b, h) ((4 + (b) * 2 + (h)) * HTB)
#define PG8_STAGE2(bufoff, gbase, voff, p2) do { const char* _g0 = (const char*)(gbase); const char* _g1 = _g0 + (p2); asm volatile("" : "+s"(_g0), "+s"(_g1));   \
        __builtin_amdgcn_global_load_lds((const unsigned*)(_g0 + (voff)), (LAS unsigned*)(lds + (bufoff) + ldsw), 16, 0, 0); \
        __builtin_amdgcn_global_load_lds((const unsigned*)(_g1 + (voff)), (LAS unsigned*)(lds + (bufoff) + ldsw + 8192), 16, 0, 0); } while (0)
#define PG8_STAGE(bufoff, gbase, voff) PG8_STAGE2(bufoff, gbase, voff, PG8_P2_##voff)
#define PG8_P2_voffA p2A
#define PG8_P2_voffB p2B
#define PG8_LD32(p_) __builtin_bit_cast(v8i32, __builtin_shufflevector(*(const LAS bf16x8*)(p_), *(const LAS bf16x8*)((p_) + 16), 0, 1, 2, 3, 4, 5, 6, 7, 8, 9, 10, 11, 12, 13, 14, 15))
#define PG8_LDA(dst, b, h) do { if constexpr (FP8) { _Pragma("unroll") for (int m = 0; m < 4; ++m) dst##8[m] = PG8_LD32(lds + PG8_SA(b, h) + aoff + m * 2048); } \
        else { _Pragma("unroll") for (int m = 0; m < 4; ++m) _Pragma("unroll") for (int k = 0; k < 2; ++k) dst[m][k] = *(const LAS bf16x8*)(lds + PG8_SA(b, h) + aoff + m * 2048 + k * 1024); } } while (0)
#define PG8_LDB(dst, b, h) do { if constexpr (FP8) { _Pragma("unroll") for (int n = 0; n < 2; ++n) dst##8[n] = PG8_LD32(lds + PG8_SB(b, h) + boff + n * 2048); } \
        else { _Pragma("unroll") for (int n = 0; n < 2; ++n) _Pragma("unroll") for (int k = 0; k < 2; ++k) dst[n][k] = *(const LAS bf16x8*)(lds + PG8_SB(b, h) + boff + n * 2048 + k * 1024); } } while (0)
#define PG8_MMA(ai, bj, At, Bt) do { __builtin_amdgcn_s_setprio(1); _Pragma("unroll") for (int m = 0; m < 4; ++m) _Pragma("unroll") for (int n = 0; n < 2; ++n) { \
        if constexpr (FP8) acc[ai][bj][m][n] = __builtin_amdgcn_mfma_scale_f32_16x16x128_f8f6f4(Bt##8[n], At##8[m], acc[ai][bj][m][n], 0, 0, 0, 0, 0, 0); \
        else { _Pragma("unroll") for (int k = 0; k < 2; ++k) acc[ai][bj][m][n] = __builtin_amdgcn_mfma_f32_16x16x32_bf16(Bt[n][k], At[m][k], acc[ai][bj][m][n], 0, 0, 0); } } \
        __builtin_amdgcn_s_setprio(0); } while (0)
#define PG8_WAIT_V(n) asm volatile("s_waitcnt vmcnt(" #n ")" ::: "memory")
#define PG8_WAIT_L(n) asm volatile("s_waitcnt lgkmcnt(" #n ")" ::: "memory")
#define PG8_BAR __builtin_amdgcn_s_barrier()
#define PG8_SCHED __builtin_amdgcn_sched_barrier(0)
    Unit cur, nxt; int ui = 0;
    if (!S.next(0, cur)) return;
    f32x4 acc[2][2][4][2]; float zf = 0.f; asm volatile("" : "+v"(zf));
#pragma unroll
    for (int a = 0; a < 2; ++a)
#pragma unroll
        for (int b = 0; b < 2; ++b)
#pragma unroll
            for (int m = 0; m < 4; ++m)
#pragma unroll
                for (int n = 0; n < 2; ++n) acc[a][b][m][n] = (f32x4){zf, zf, zf, zf};
    bf16x8 At[4][2], B0[2][2], B1[2][2]; v8i32 At8[4], B08[2], B18[2];
    const char* cA = (const char*)g.A + (size_t)cur.pm * tstepA + (size_t)cur.k0 * ESZ; const char* cB = (const char*)g.Bt + (size_t)cur.pb * tstepB + (size_t)cur.k0 * ESZ;
    PG8_STAGE(PG8_SB(0, 0), cB, voffB); PG8_STAGE(PG8_SB(0, 1), cB + hstepB, voffB); PG8_STAGE(PG8_SA(0, 0), cA, voffA); PG8_STAGE(PG8_SA(0, 1), cA + hstepA, voffA);
    if (wr == 1) PG8_BAR;
    PG8_WAIT_V(2); PG8_BAR;
    PG8_STAGE(PG8_SB(1, 0), cB + kstep, voffB); PG8_STAGE(PG8_SA(1, 0), cA + kstep, voffA); PG8_STAGE(PG8_SB(1, 1), cB + hstepB + kstep, voffB);
    PG8_WAIT_V(6); PG8_BAR;
    for (;;) {
        const bool has_next = S.next(ui + 1, nxt);
        const char* nA = has_next ? (const char*)g.A + (size_t)nxt.pm * tstepA + (size_t)nxt.k0 * ESZ : cA; const char* nB = has_next ? (const char*)g.Bt + (size_t)nxt.pb * tstepB + (size_t)nxt.k0 * ESZ : cB;
        const int unt = cur.nt ? cur.nt : nt;
        for (int t = 0; t < unt; t += 2) {
            const bool last = (t == unt - 2);
            const char* a1 = cA + (size_t)(t + 1) * kstep;
            const char* a2 = last ? nA : cA + (size_t)(t + 2) * kstep; const char* b2 = last ? nB : cB + (size_t)(t + 2) * kstep;
            const char* a3 = a2 + kstep; const char* b3 = b2 + kstep;
            if constexpr (!FP8) if (E.mode == EP_MERGEF && (t == 8 || t == 12)) {
                const unsigned char* va = (const unsigned char*)E.gt + (t == 8 ? 0 : 1024); const int tl = lane_id_l(); const int frl = tl & 15, fql = tl >> 4;
#pragma unroll
                for (int ai = 0; ai < 2; ++ai) {
                    u32x2 ga[4][2], gb[4][2];
#pragma unroll
                    for (int m = 0; m < 4; ++m)
#pragma unroll
                        for (int bj = 0; bj < 2; ++bj) {
                            const size_t off = (size_t)(cur.pm * BM + ai * HALF + wr * 64 + m * 16 + frl) * 3072 + cur.pn * BM + bj * HALF + wc * 32 + 8 * fql;
                            ga[m][bj] = *(const u32x2*)(va + off); gb[m][bj] = *(const u32x2*)(va + 1024 + off); }
                    __builtin_amdgcn_sched_barrier(0);
#pragma unroll
                    for (int m = 0; m < 4; ++m)
#pragma unroll
                        for (int bj = 0; bj < 2; ++bj) {
#pragma unroll
                            for (int e = 0; e < 4; ++e) { acc[ai][bj][m][0][e] *= __builtin_amdgcn_exp2f((ub(gb[m][bj].x, e) - ub(ga[m][bj].x, e)) * 0.03125f); acc[ai][bj][m][1][e] *= __builtin_amdgcn_exp2f((ub(gb[m][bj].y, e) - ub(ga[m][bj].y, e)) * 0.03125f); } }
                    __builtin_amdgcn_sched_barrier(0);
                }
            }
            PG8_LDB(B0, 0, 0); PG8_LDB(B1, 0, 1); PG8_SCHED; PG8_LDA(At, 0, 0); PG8_STAGE(PG8_SA(1, 1), a1 + hstepA, voffA);
            PG8_WAIT_V(8); PG8_WAIT_L(0); PG8_BAR; PG8_MMA(0, 0, At, B0); PG8_MMA(0, 1, At, B1); PG8_BAR; PG8_SCHED;
            PG8_LDA(At, 0, 1); PG8_STAGE(PG8_SB(0, 0), b2, voffB); PG8_STAGE(PG8_SB(0, 1), b2 + hstepB, voffB); PG8_STAGE(PG8_SA(0, 0), a2, voffA);
            PG8_WAIT_V(8); PG8_WAIT_L(0); PG8_BAR; PG8_MMA(1, 0, At, B0); PG8_MMA(1, 1, At, B1); PG8_BAR; PG8_SCHED;
            PG8_LDB(B0, 1, 0); PG8_LDB(B1, 1, 1); PG8_SCHED; PG8_LDA(At, 1, 0); PG8_STAGE(PG8_SA(0, 1), a2 + hstepA, voffA);
            PG8_WAIT_V(8); PG8_WAIT_L(0); PG8_BAR; PG8_MMA(0, 0, At, B0); PG8_MMA(0, 1, At, B1); PG8_BAR; PG8_SCHED;
            PG8_LDA(At, 1, 1); PG8_STAGE(PG8_SB(1, 0), b3, voffB); PG8_STAGE(PG8_SB(1, 1), b3 + hstepB, voffB); PG8_STAGE(PG8_SA(1, 0), a3, voffA);
            PG8_WAIT_V(8); PG8_WAIT_L(0); PG8_BAR; PG8_MMA(1, 0, At, B0); PG8_MMA(1, 1, At, B1); PG8_BAR; PG8_SCHED;
        }
        if (wr == 0) PG8_BAR;
        if (!E.after_drain) { const int tl = lane_id_l(); E.template run<FP8>(acc, cur, wr, wc, tl & 15, tl >> 4, lds); }
        if (!has_next) break;
        float zf2 = 0.f; asm volatile("" : "+v"(zf2));
#pragma unroll
        for (int a = 0; a < 2; ++a)
#pragma unroll
            for (int b = 0; b < 2; ++b)
#pragma unroll
                for (int m = 0; m < 4; ++m)
#pragma unroll
                    for (int n = 0; n < 2; ++n) acc[a][b][m][n] = (f32x4){zf2, zf2, zf2, zf2};
        cur = nxt; cA = nA; cB = nB; ++ui;
        if (wr == 1) PG8_BAR;
    }
    PG8_WAIT_V(0);
    PG8_BAR;
    if constexpr (!FP8) if (E.after_drain) { const int tl = lane_id_l(); E.fused(acc, cur, wr, wc, tl & 15, tl >> 4, lds, wid * 64 + tl); }
#undef PG8_SA
#undef PG8_SB
#undef PG8_STAGE
#undef PG8_STAGE2
#undef PG8_P2_voffA
#undef PG8_P2_voffB
#undef PG8_LDA
#undef PG8_LDB
#undef PG8_MMA
#undef PG8_WAIT_V
#undef PG8_WAIT_L
#undef PG8_BAR
#undef PG8_SCHED
}

#define XB_TMO      128
#define XB_XCNT(j)  (256  + 64 * (j))
#define XB_XSUB(j)  (1280 + 64 * (j))
#define XB_XGEN(j)  (2304 + 64 * (j))
#define XB_TOP      3328
#define XB_TOPGEN   3392
#define XCD_BAR_WORDS 3456
#define XB_SPIN_CAP (1u << 22)
__device__ __forceinline__ unsigned xb_ld(unsigned* p)              { return __hip_atomic_load(p, __ATOMIC_RELAXED, __HIP_MEMORY_SCOPE_AGENT); }
__device__ __forceinline__ unsigned xb_add(unsigned* p, unsigned v) { return __hip_atomic_fetch_add(p, v, __ATOMIC_RELAXED, __HIP_MEMORY_SCOPE_AGENT); }
__device__ __forceinline__ unsigned xb_xcc_id() { return (unsigned)__builtin_amdgcn_s_getreg((3 << 11) | 20) & 0xFu; }
#define XB_SPIN(cond, bar) do { unsigned _sp = 0; while (cond) { __builtin_amdgcn_s_sleep(1); \
    if ((++_sp & 255u) == 0u) { if (xb_ld(&(bar)[XB_TMO])) break; if (_sp > XB_SPIN_CAP) { atomicAdd(&(bar)[XB_TMO], 1u); break; } } } } while (0)
struct XcdBarrier { unsigned* bar; unsigned x; volatile LAS unsigned* st; };
__device__ __forceinline__ XcdBarrier xcd_barrier_post(unsigned* bar, volatile LAS unsigned* st) {
    XcdBarrier b; b.bar = bar; b.x = xb_xcc_id(); b.st = st;
    if (threadIdx.x == 0) (void)xb_add(&bar[XB_XCNT(b.x)], 1u);
    return b;
}
__device__ __forceinline__ void xcd_barrier_complete(unsigned* bar, unsigned x, unsigned& nloc, unsigned& nx) {
    const unsigned G = gridDim.x * gridDim.y * gridDim.z;
    unsigned sum, cnt, mine, sp = 0u;
    for (;;) {
        sum = 0u; cnt = 0u; mine = 0u;
#pragma unroll
        for (unsigned j = 0; j < 16; ++j) { const unsigned c = xb_ld(&bar[XB_XCNT(j)]); sum += c; cnt += (c > 0u) ? 1u : 0u; mine = (j == x) ? c : mine; }
        if (sum == G) break;
        __builtin_amdgcn_s_sleep(1);
        if ((++sp & 255u) == 0u) { if (xb_ld(&bar[XB_TMO])) break; if (sp > XB_SPIN_CAP) { atomicAdd(&bar[XB_TMO], 1u); break; } }
    }
    nloc = mine > 0u ? mine : 1u; nx = cnt > 0u ? cnt : 1u;
}
__device__ __forceinline__ void xcd_barrier(const XcdBarrier& b) {
    asm volatile("s_waitcnt vmcnt(0)" ::: "memory");
    __syncthreads();
    if (threadIdx.x == 0) {
        unsigned* bar = b.bar; asm volatile("" : "+v"(bar));
        __builtin_amdgcn_s_waitcnt(0);
        unsigned nloc = b.st[0], nx = b.st[1];
        if (nloc == 0u) { xcd_barrier_complete(bar, b.x, nloc, nx); b.st[0] = nloc; b.st[1] = nx; }
        const unsigned old = xb_add(&bar[XB_XSUB(b.x)], 1u);
        const unsigned gen = old / nloc;
        if (old + 1u == (gen + 1u) * nloc) {
            __builtin_amdgcn_fence(__ATOMIC_RELEASE, "agent");
            asm volatile("s_waitcnt vmcnt(0)" ::: "memory");
            const unsigned og = xb_add(&bar[XB_TOP], 1u);
            const unsigned tg = og / nx;
            if (og + 1u == (tg + 1u) * nx) xb_add(&bar[XB_TOPGEN], 1u);
            else XB_SPIN(xb_ld(&bar[XB_TOPGEN]) == tg, bar);
            __builtin_amdgcn_fence(__ATOMIC_ACQUIRE, "agent");
            xb_add(&bar[XB_XGEN(b.x)], 1u);
            asm volatile("s_waitcnt vmcnt(0)" ::: "memory");
        } else {
            XB_SPIN(xb_ld(&bar[XB_XGEN(b.x)]) == gen, bar);
            __builtin_amdgcn_fence(__ATOMIC_ACQUIRE, "agent");
            asm volatile("s_waitcnt vmcnt(0)" ::: "memory");
        }
    }
    __syncthreads();
}

__device__ __forceinline__ void transpose_item(const float* W, int K, int N, bf16_t* WT, int ldw, int dst_row0, LAS float* scr, int k0, int n0, int lane, const float* gain = nullptr) {
    const int kr = lane >> 3, c4 = lane & 7;
    f32x4 v[8];
#pragma unroll
    for (int i = 0; i < 8; ++i) v[i] = *(const f32x4*)(W + (size_t)(k0 + kr + 8 * i) * N + n0 + 4 * c4);
    if (gain) {
#pragma unroll
        for (int i = 0; i < 8; ++i) v[i] = v[i] * gain[k0 + kr + 8 * i]; }
#pragma unroll
    for (int i = 0; i < 8; ++i) { LAS float* d = scr + (kr + 8 * i) * 33 + 4 * c4; d[0] = v[i].x; d[1] = v[i].y; d[2] = v[i].z; d[3] = v[i].w; }
    LDS_WAIT(); asm volatile("" ::: "memory");
    const int c = lane & 7;
#pragma unroll
    for (int j = 0; j < 4; ++j) { const int n = (lane >> 3) + 8 * j; const LAS float* s = scr + (8 * c) * 33 + n;
        u32x4 o; o.x = pk2(s[0 * 33], s[1 * 33]); o.y = pk2(s[2 * 33], s[3 * 33]); o.z = pk2(s[4 * 33], s[5 * 33]); o.w = pk2(s[6 * 33], s[7 * 33]);
        *(u32x4*)(WT + (size_t)(dst_row0 + n) * ldw + k0 + 8 * c) = o; }
    LDS_WAIT(); asm volatile("" ::: "memory");
}
__device__ __forceinline__ void tr_plain(const float* W, int K, int N, bf16_t* WT, int ldw, LAS float* scr, int r, int lane, const float* gain = nullptr) {
    const int nblk = N / 32, kb = r / nblk, nb = r % nblk; transpose_item(W, K, N, WT, ldw, 32 * nb, scr, 64 * kb, 32 * nb, lane, gain);
}
__device__ __forceinline__ void tr_pair(const float* W, int K, int N, int col0, int ncols, bf16_t* WT, int half, LAS float* scr, int r, int lane, const float* gain = nullptr) {
    const int nblk = ncols / 32, kb = r / nblk, nb = r % nblk, c = 32 * nb;
    transpose_item(W, K, N, WT, K, 256 * (c >> 7) + (c & 127) + half * 128, scr, 64 * kb, col0 + c, lane, gain);
}
__device__ __forceinline__ void transpose_item_q(const float* W, int K, int N, unsigned char* WT, int dst_row0, LAS float* scr, int k0, int n0, int lane, float scale) {
    const int kr = lane >> 3, c4 = lane & 7;
    f32x4 v[8];
#pragma unroll
    for (int i = 0; i < 8; ++i) v[i] = *(const f32x4*)(W + (size_t)(k0 + kr + 8 * i) * N + n0 + 4 * c4);
#pragma unroll
    for (int i = 0; i < 8; ++i) { LAS float* d = scr + (kr + 8 * i) * 33 + 4 * c4; d[0] = v[i].x; d[1] = v[i].y; d[2] = v[i].z; d[3] = v[i].w; }
    LDS_WAIT(); asm volatile("" ::: "memory");
    const int c = lane & 3;
#pragma unroll
    for (int j = 0; j < 2; ++j) { const int n = (lane >> 2) + 16 * j; const LAS float* s = scr + (16 * c) * 33 + n; float x[16];
#pragma unroll
        for (int e = 0; e < 16; ++e) x[e] = clamp448(s[e * 33] * scale);
        u32x4 o; o.x = pk4_fp8(x[0], x[1], x[2], x[3]); o.y = pk4_fp8(x[4], x[5], x[6], x[7]); o.z = pk4_fp8(x[8], x[9], x[10], x[11]); o.w = pk4_fp8(x[12], x[13], x[14], x[15]);
        *(u32x4*)(WT + (size_t)(dst_row0 + n) * K + k0 + 16 * c) = o; }
    LDS_WAIT(); asm volatile("" ::: "memory");
}
__device__ __forceinline__ void tr_pair_q(const float* W, int K, int N, unsigned char* WT, int half, LAS float* scr, int r, int lane, float scale) {
    const int nblk = N / 32, kb = r / nblk, nb = r % nblk, c = 32 * nb;
    transpose_item_q(W, K, N, WT, 256 * (c >> 7) + (c & 127) + half * 128, scr, 64 * kb, c, lane, scale);
}
__device__ __forceinline__ int sample_sexp(const float* W, int lane) {
    const f32x4 w4 = *(const f32x4*)(W + 4 * lane); float ss = (w4.x * w4.x + w4.y * w4.y) + (w4.z * w4.z + w4.w * w4.w);
    ss = wave_sum(ss, lane); const float rms = sqrtf(ss * (1.f / 256.f));
    int se = 3 - (int)rintf(__builtin_amdgcn_logf(fmaxf(rms, 1e-30f))); return se < -100 ? -100 : (se > 100 ? 100 : se);
}
struct TrDesc { const float* src; unsigned char* dst; const float* gain; int N, ldw, drow0, k0, n0, q; float scale; };
__device__ __forceinline__ void trd_plain(TrDesc& d, const float* W, int N, void* WT, int ldw, int r, const float* gain, int q, float scale) {
    const int nblk = N / 32, kb = r / nblk, nb = r % nblk; d.src = W; d.dst = (unsigned char*)WT; d.gain = gain; d.N = N; d.ldw = ldw; d.drow0 = 32 * nb; d.k0 = 64 * kb; d.n0 = 32 * nb; d.q = q; d.scale = scale; }
__device__ __forceinline__ void trd_pair(TrDesc& d, const float* W, int K, int N, int col0, int ncols, void* WT, int half, int r, const float* gain, int q, float scale) {
    const int nblk = ncols / 32, kb = r / nblk, nb = r % nblk, c = 32 * nb; d.src = W; d.dst = (unsigned char*)WT; d.gain = gain; d.N = N; d.ldw = K; d.drow0 = 256 * (c >> 7) + (c & 127) + half * 128; d.k0 = 64 * kb; d.n0 = col0 + c; d.q = q; d.scale = scale; }
__device__ __forceinline__ void trd_load(const TrDesc& d, f32x4 (&v)[8], int lane) {
    const int kr = lane >> 3, c4 = lane & 7;
#pragma unroll
    for (int i = 0; i < 8; ++i) v[i] = __builtin_nontemporal_load((const f32x4*)(d.src + (size_t)(d.k0 + kr + 8 * i) * d.N + d.n0 + 4 * c4));
}
__device__ __forceinline__ void trd_finish(const TrDesc& d, f32x4 (&v)[8], LAS float* scr, int lane) {
    const int kr = lane >> 3, c4 = lane & 7;
    if (d.gain) {
#pragma unroll
        for (int i = 0; i < 8; ++i) v[i] = v[i] * d.gain[d.k0 + kr + 8 * i]; }
#pragma unroll
    for (int i = 0; i < 8; ++i) { LAS float* p = scr + (kr + 8 * i) * 33 + 4 * c4; p[0] = v[i].x; p[1] = v[i].y; p[2] = v[i].z; p[3] = v[i].w; }
    LDS_WAIT(); asm volatile("" ::: "memory");
    if (d.q) { const int c = lane & 3;
#pragma unroll
        for (int j = 0; j < 2; ++j) { const int n = (lane >> 2) + 16 * j; const LAS float* s = scr + (16 * c) * 33 + n; float x[16];
#pragma unroll
            for (int e = 0; e < 16; ++e) x[e] = clamp448(s[e * 33] * d.scale);
            u32x4 o; o.x = pk4_fp8(x[0], x[1], x[2], x[3]); o.y = pk4_fp8(x[4], x[5], x[6], x[7]); o.z = pk4_fp8(x[8], x[9], x[10], x[11]); o.w = pk4_fp8(x[12], x[13], x[14], x[15]);
            *(u32x4*)(d.dst + (size_t)(d.drow0 + n) * d.ldw + d.k0 + 16 * c) = o; }
    } else { const int c = lane & 7;
#pragma unroll
        for (int j = 0; j < 4; ++j) { const int n = (lane >> 3) + 8 * j; const LAS float* s = scr + (8 * c) * 33 + n;
            u32x4 o; o.x = pk2(s[0 * 33], s[1 * 33]); o.y = pk2(s[2 * 33], s[3 * 33]); o.z = pk2(s[4 * 33], s[5 * 33]); o.w = pk2(s[6 * 33], s[7 * 33]);
            *(u32x4*)((bf16_t*)d.dst + (size_t)(d.drow0 + n) * d.ldw + d.k0 + 8 * c) = o; }
    }
    LDS_WAIT(); asm volatile("" ::: "memory");
}
__device__ __forceinline__ void rms_row(const float* xrow, const float* gain, bf16_t* orow, int lane, f32x4 (&v)[4], unsigned char* o8row = nullptr) {
    const f32x4* xr = (const f32x4*)xrow + lane; float s = 0.f;
#pragma unroll
    for (int j = 0; j < 4; ++j) { v[j] = __builtin_nontemporal_load(xr + 64 * j); s += (v[j].x * v[j].x + v[j].y * v[j].y) + (v[j].z * v[j].z + v[j].w * v[j].w); }
    const float r = 1.0f / sqrtf(wave_sum(s, lane) * (1.f / DM) + EPS);
    const f32x4* gr = (const f32x4*)gain + lane;
    u32x2* o8 = (u32x2*)orow + lane;
#pragma unroll
    for (int j = 0; j < 4; ++j) { const f32x4 g = gr[64 * j]; v[j] = v[j] * r * g; u32x2 w; w.x = pk2(v[j].x, v[j].y); w.y = pk2(v[j].z, v[j].w); o8[64 * j] = w;
        if (o8row) ((unsigned*)o8row)[lane + 64 * j] = pk4_fp8(clamp448(16.f * v[j].x), clamp448(16.f * v[j].y), clamp448(16.f * v[j].z), clamp448(16.f * v[j].w)); }
}

__device__ __forceinline__ void rms_row_pre(const f32x4 (&xv)[4], const f32x4 (&g)[4], bf16_t* orow, int lane, unsigned char* o8row) {
    float s = 0.f;
#pragma unroll
    for (int j = 0; j < 4; ++j) s += (xv[j].x * xv[j].x + xv[j].y * xv[j].y) + (xv[j].z * xv[j].z + xv[j].w * xv[j].w);
    const float r = 1.0f / sqrtf(wave_sum(s, lane) * (1.f / DM) + EPS);
    u32x2* o8 = (u32x2*)orow + lane;
#pragma unroll
    for (int j = 0; j < 4; ++j) { const f32x4 v = xv[j] * r * g[j]; u32x2 w; w.x = pk2(v.x, v.y); w.y = pk2(v.z, v.w); o8[64 * j] = w;
        ((unsigned*)o8row)[lane + 64 * j] = pk4_fp8(clamp448(16.f * v.x), clamp448(16.f * v.y), clamp448(16.f * v.z), clamp448(16.f * v.w)); }
}
__device__ __forceinline__ void rms_row_b(const bf16_t* xrow, const float* gain, bf16_t* orow, int lane, f32x4 (&v)[4]) {
    const u32x4* xr = (const u32x4*)xrow + lane; float s = 0.f;
#pragma unroll
    for (int j = 0; j < 2; ++j) { const u32x4 r = xr[64 * j]; v[2 * j] = (f32x4){bflo(r.x), bfhi(r.x), bflo(r.y), bfhi(r.y)}; v[2 * j + 1] = (f32x4){bflo(r.z), bfhi(r.z), bflo(r.w), bfhi(r.w)}; }
#pragma unroll
    for (int j = 0; j < 4; ++j) s += (v[j].x * v[j].x + v[j].y * v[j].y) + (v[j].z * v[j].z + v[j].w * v[j].w);
    const float r = 1.0f / sqrtf(wave_sum(s, lane) * (1.f / DM) + EPS);
    u32x4* o8 = (u32x4*)orow + lane;
#pragma unroll
    for (int j = 0; j < 2; ++j) { const f32x4 g0 = *(const f32x4*)(gain + 8 * lane + 512 * j), g1 = *(const f32x4*)(gain + 8 * lane + 512 * j + 4);
        v[2 * j] = v[2 * j] * r * g0; v[2 * j + 1] = v[2 * j + 1] * r * g1;
        u32x4 w; w.x = pk2(v[2 * j].x, v[2 * j].y); w.y = pk2(v[2 * j].z, v[2 * j].w); w.z = pk2(v[2 * j + 1].x, v[2 * j + 1].y); w.w = pk2(v[2 * j + 1].z, v[2 * j + 1].w); o8[64 * j] = w; }
}
__device__ __forceinline__ void rms_row_b_pre(const u32x4 r0, const u32x4 r1, const f32x4 (&g)[4], bf16_t* orow, int lane, f32x4 (&v)[4]) {
    v[0] = (f32x4){bflo(r0.x), bfhi(r0.x), bflo(r0.y), bfhi(r0.y)}; v[1] = (f32x4){bflo(r0.z), bfhi(r0.z), bflo(r0.w), bfhi(r0.w)};
    v[2] = (f32x4){bflo(r1.x), bfhi(r1.x), bflo(r1.y), bfhi(r1.y)}; v[3] = (f32x4){bflo(r1.z), bfhi(r1.z), bflo(r1.w), bfhi(r1.w)};
    float s = 0.f;
#pragma unroll
    for (int j = 0; j < 4; ++j) s += (v[j].x * v[j].x + v[j].y * v[j].y) + (v[j].z * v[j].z + v[j].w * v[j].w);
    const float r = 1.0f / sqrtf(wave_sum(s, lane) * (1.f / DM) + EPS);
    u32x4* o8 = (u32x4*)orow + lane;
#pragma unroll
    for (int j = 0; j < 2; ++j) { v[2 * j] = v[2 * j] * r * g[2 * j]; v[2 * j + 1] = v[2 * j + 1] * r * g[2 * j + 1];
        u32x4 w; w.x = pk2(v[2 * j].x, v[2 * j].y); w.y = pk2(v[2 * j].z, v[2 * j].w); w.z = pk2(v[2 * j + 1].x, v[2 * j + 1].y); w.w = pk2(v[2 * j + 1].z, v[2 * j + 1].w); __builtin_nontemporal_store(w, o8 + 64 * j); }
}
__device__ __forceinline__ void ssm_table_wave(LAS unsigned char* wl, int lane, int g, int tau, const float* a_re, const float* a_im, const float* log_dt, const float* b_re, const float* b_im,
                                               const float* c_re, const float* c_im, float* Ptab  , float* Ktab  , bf16_t* Winp  ) {
    LAS f32x2* EB = (LAS f32x2*)wl; LAS f32x2* Cc = (LAS f32x2*)(wl + 8192);
    const int p = lane;
    const float dt = __expf(log_dt[g]), ar = a_re[g * 64 + p], ai = a_im[g * 64 + p];
    const float mg = __expf(ar * dt * (float)tau); float tr = ai * dt * (float)tau * 0.15915494309189535f; tr -= rintf(tr);
    const float Er = mg * __builtin_amdgcn_cosf(tr), Ei = mg * __builtin_amdgcn_sinf(tr);
    *(f32x2*)(Ptab + ((size_t)(g * 33 + tau) * 64 + p) * 2) = (f32x2){Er, Ei};
    if (tau >= 32) return;
    const float m1 = __expf(ar * dt); float t1 = ai * dt * 0.15915494309189535f; t1 -= rintf(t1);
    const float nr = m1 * __builtin_amdgcn_cosf(t1) - 1.0f, ni = m1 * __builtin_amdgcn_sinf(t1), den = ar * ar + ai * ai;
    const float fr = (nr * ar + ni * ai) / den, fi = (ni * ar - nr * ai) / den;
    const float efr = Er * fr - Ei * fi, efi = Er * fi + Ei * fr;
#pragma unroll
    for (int c = 0; c < 16; ++c) Cc[c * 64 + p] = (f32x2){c_re[(g * 16 + c) * 64 + p], c_im[(g * 16 + c) * 64 + p]};
    float er[16], ei[16];
#pragma unroll
    for (int j = 0; j < 4; ++j) { const f32x4 br = *(const f32x4*)(b_re + (g * 64 + p) * 16 + 4 * j), bi = *(const f32x4*)(b_im + (g * 64 + p) * 16 + 4 * j);
#pragma unroll
        for (int e = 0; e < 4; ++e) { er[4 * j + e] = efr * br[e] - efi * bi[e]; ei[4 * j + e] = efr * bi[e] + efi * br[e]; EB[p * 16 + 4 * j + e] = (f32x2){er[4 * j + e], ei[4 * j + e]}; } }
    { bf16_t* wp = Winp + ((size_t)(g * 256 + 2 * p)) * 512 + (31 - tau) * 16; u32x4 w0, w1;
      w0.x = pk2(er[0], er[1]); w0.y = pk2(er[2], er[3]); w0.z = pk2(er[4], er[5]); w0.w = pk2(er[6], er[7]); w1.x = pk2(er[8], er[9]); w1.y = pk2(er[10], er[11]); w1.z = pk2(er[12], er[13]); w1.w = pk2(er[14], er[15]);
      *(u32x4*)wp = w0; *(u32x4*)(wp + 8) = w1;
      w0.x = pk2(ei[0], ei[1]); w0.y = pk2(ei[2], ei[3]); w0.z = pk2(ei[4], ei[5]); w0.w = pk2(ei[6], ei[7]); w1.x = pk2(ei[8], ei[9]); w1.y = pk2(ei[10], ei[11]); w1.z = pk2(ei[12], ei[13]); w1.w = pk2(ei[14], ei[15]);
      *(u32x4*)(wp + 512) = w0; *(u32x4*)(wp + 512 + 8) = w1; }
    LDS_WAIT(); asm volatile("" ::: "memory");
    const int cp = lane & 15, cq = lane >> 4; float s0 = 0.f, s1 = 0.f, s2 = 0.f, s3 = 0.f;
#pragma unroll 4
    for (int q = 0; q < 64; ++q) { const f32x2 eb = EB[q * 16 + cp]; const f32x2 c0 = Cc[cq * 64 + q], c1 = Cc[(cq + 4) * 64 + q], c2 = Cc[(cq + 8) * 64 + q], c3 = Cc[(cq + 12) * 64 + q];
        s0 += c0.x * eb.x - c0.y * eb.y; s1 += c1.x * eb.x - c1.y * eb.y; s2 += c2.x * eb.x - c2.y * eb.y; s3 += c3.x * eb.x - c3.y * eb.y; }
    float* kp = Ktab + ((size_t)(g * 32 + tau)) * 256 + cp;
    kp[cq * 16] = s0; kp[(cq + 4) * 16] = s1; kp[(cq + 8) * 16] = s2; kp[(cq + 12) * 16] = s3;
    LDS_WAIT(); asm volatile("" ::: "memory");
}
__device__ __forceinline__ void ssm_expand_row(int rr, int lane, const float* Ptab, const float* Ktab, const float* c_re, const float* c_im, const float* dskip  , bf16_t* W) {
    const int g = rr >> 9, tc = rr & 511, t = tc >> 4, c = tc & 15, s = lane;
    bf16_t* dst = W + (size_t)rr * 640;
    if (s < 32) {
        f32x4 k4[4];
        if (s <= t) { const f32x4* kp = (const f32x4*)(Ktab + ((size_t)(g * 32 + (t - s))) * 256 + c * 16);
#pragma unroll
            for (int j = 0; j < 4; ++j) k4[j] = kp[j];
            if (s == t) { const float dk = dskip[g * 16 + c];
#pragma unroll
                for (int j = 0; j < 4; ++j)
#pragma unroll
                    for (int e = 0; e < 4; ++e) k4[j][e] += (4 * j + e == c) ? dk : 0.f; }
        } else {
#pragma unroll
            for (int j = 0; j < 4; ++j) k4[j] = (f32x4){0.f, 0.f, 0.f, 0.f};
        }
        u32x4 w0, w1; w0.x = pk2(k4[0].x, k4[0].y); w0.y = pk2(k4[0].z, k4[0].w); w0.z = pk2(k4[1].x, k4[1].y); w0.w = pk2(k4[1].z, k4[1].w);
        w1.x = pk2(k4[2].x, k4[2].y); w1.y = pk2(k4[2].z, k4[2].w); w1.z = pk2(k4[3].x, k4[3].y); w1.w = pk2(k4[3].z, k4[3].w);
        *(u32x4*)(dst + s * 16) = w0; *(u32x4*)(dst + s * 16 + 8) = w1;
    }
    const int p = lane; const float cr = c_re[(g * 16 + c) * 64 + p], ci = c_im[(g * 16 + c) * 64 + p];
    const f32x2 P = *(const f32x2*)(Ptab + ((size_t)(g * 33 + t + 1) * 64 + p) * 2);
    *(unsigned*)(dst + 512 + 2 * p) = pk2(cr * P.x - ci * P.y, -(cr * P.y + ci * P.x));
}

template <int HD, int MODE>
__device__ __forceinline__ void attn_stage(LAS unsigned char* lds, int tid, const bf16_t* Kp, const bf16_t* Vp, long kv_rstride, int first_valid,
                                           const float* gk, const float* ropeK, long rope_stride) {
    constexpr int CPR = HD / 8, PIECES = 256 * CPR / 512, PB = PIECES < 4 ? PIECES : 4;
    const int c = tid % CPR, lane = tid & 63;
    float gkv[8];
    { const f32x4 g0 = *(const f32x4*)(gk + c * 8), g1 = *(const f32x4*)(gk + c * 8 + 4); gkv[0] = g0.x; gkv[1] = g0.y; gkv[2] = g0.z; gkv[3] = g0.w; gkv[4] = g1.x; gkv[5] = g1.y; gkv[6] = g1.z; gkv[7] = g1.w; }
    (void)ropeK; (void)rope_stride;
#pragma nounroll
    for (int ib = 0; ib < PIECES; ib += PB) {
        u32x4 kv[PB], vv[PB];
#pragma unroll
        for (int i = 0; i < PB; ++i) { const int key = tid / CPR + (512 / CPR) * (ib + i), kk = key < first_valid ? first_valid : key;
            kv[i] = *(const u32x4*)(Kp + (long)kk * kv_rstride + c * 8); vv[i] = *(const u32x4*)(Vp + (long)kk * kv_rstride + c * 8); }
#pragma unroll
        for (int i = 0; i < PB; ++i) { const int key = tid / CPR + (512 / CPR) * (ib + i);
            float x[8] = {bflo(kv[i].x), bfhi(kv[i].x), bflo(kv[i].y), bfhi(kv[i].y), bflo(kv[i].z), bfhi(kv[i].z), bflo(kv[i].w), bfhi(kv[i].w)};
            float ss = 0.f;
#pragma unroll
            for (int e = 0; e < 8; ++e) ss += x[e] * x[e];
            if (CPR == 16) ss = rowsum16(ss); else {
#pragma unroll
                for (int o = 1; o < CPR; o <<= 1) ss += shx(ss, o, lane); }
            const float r = (MODE == 0) ? 1.0f : 1.0f / sqrtf(ss * (1.f / HD) + EPS);
#pragma unroll
            for (int e = 0; e < 8; ++e) x[e] = (MODE == 0) ? x[e] : x[e] * r * gkv[e];
            u32x4 w; w.x = pk2(x[0], x[1]); w.y = pk2(x[2], x[3]); w.z = pk2(x[4], x[5]); w.w = pk2(x[6], x[7]);
            *(LAS u32x4*)(lds + (c * 256 + key) * 16) = w;
            *(LAS u32x4*)(lds + 256 * HD * 2 + ((c >> 1) * 256 + key) * 32 + (c & 1) * 16) = vv[i]; }
    }
}
__device__ __forceinline__ void attn_dma64(LAS unsigned char* lds, int buf, int wave, int lane, const bf16_t* Kp, const bf16_t* Vp, long kv_rstride, int first_valid) {
#pragma unroll
    for (int i = 0; i < 4; ++i) { const int P = wave * 4 + i, c = P >> 2, kg = P & 3; int key = kg * 64 + lane; key = key < first_valid ? first_valid : key;
        __builtin_amdgcn_global_load_lds((const unsigned*)(Kp + (long)key * kv_rstride + c * 8), (LAS unsigned*)(lds + buf + (c * 256 + kg * 64) * 16), 16, 0, 0); }
#pragma unroll
    for (int i = 0; i < 4; ++i) { const int P = wave * 4 + i, dt = P >> 3, kg = P & 7; int key = kg * 32 + (lane >> 1); key = key < first_valid ? first_valid : key;
        __builtin_amdgcn_global_load_lds((const unsigned*)(Vp + (long)key * kv_rstride + dt * 16 + (lane & 1) * 8), (LAS unsigned*)(lds + buf + 32768 + (dt * 256 + kg * 32) * 32), 16, 0, 0); }
}
struct NextDma { int has, buf, fv; const bf16_t* Kp; const bf16_t* Vp; long stride; };
template <int HD, int MODE>
__device__ __forceinline__ void attn_compute(LAS unsigned char* lds, int wid, int lane, const bf16_t* Qp, long q_rstride, const float* gq, const float* ropeQ, long rope_stride,
                                             int first_valid, bf16_t* Op, long o_rstride, float* lsep, long lse_stride, LAS unsigned char* lds0 = nullptr, const NextDma nd = NextDma{0, 0, 0, nullptr, nullptr, 0}, const u32x4 qpre0 = (u32x4){0u, 0u, 0u, 0u}, const u32x4 qpre1 = (u32x4){0u, 0u, 0u, 0u}) {
    constexpr int KS = HD / 32, DT = HD / 16;
    constexpr int NKT = (MODE == 0) ? 9 : 16, NG = (MODE == 0) ? 5 : 8;
    const int kt0 = (MODE == 0) ? wid : 0;
    const int qn = lane & 15, kq = lane >> 4;
    const float SC = (HD == 64 ? 0.125f : 0.08838834764831845f) * LOG2E;
    bf16x8 qf[KS];
    if (MODE == 0) { qf[0] = __builtin_bit_cast(bf16x8, qpre0); qf[KS - 1] = __builtin_bit_cast(bf16x8, qpre1); }
    else {
        const bf16_t* qrow = Qp + (long)(16 * wid + qn) * q_rstride;
        float x[KS][8]; float ss = 0.f;
#pragma unroll
        for (int ks = 0; ks < KS; ++ks) { const u32x4 q4 = *(const u32x4*)(qrow + 32 * ks + 8 * kq);
            x[ks][0] = bflo(q4.x); x[ks][1] = bfhi(q4.x); x[ks][2] = bflo(q4.y); x[ks][3] = bfhi(q4.y); x[ks][4] = bflo(q4.z); x[ks][5] = bfhi(q4.z); x[ks][6] = bflo(q4.w); x[ks][7] = bfhi(q4.w);
#pragma unroll
            for (int e = 0; e < 8; ++e) ss += x[ks][e] * x[ks][e]; }
        ss = xsum4(ss);
        const float r = SC / sqrtf(ss * (1.f / HD) + EPS);
        if (MODE != 0) {
#pragma unroll
        for (int ks = 0; ks < KS; ++ks)
#pragma unroll
            for (int e = 0; e < 8; ++e) x[ks][e] = x[ks][e] * r * gq[32 * ks + 8 * kq + e]; }
        if (false) {
            const f32x4* rp = (const f32x4*)(ropeQ + (long)(16 * wid + qn) * rope_stride + kq * 16);
#pragma unroll
            for (int j = 0; j < 4; ++j) { const f32x4 t4 = rp[j];
                { const float x1 = x[0][2 * j], x2 = x[KS - 1][2 * j]; x[0][2 * j] = x1 * t4.x - x2 * t4.y; x[KS - 1][2 * j] = x1 * t4.y + x2 * t4.x; }
                { const float x1 = x[0][2 * j + 1], x2 = x[KS - 1][2 * j + 1]; x[0][2 * j + 1] = x1 * t4.z - x2 * t4.w; x[KS - 1][2 * j + 1] = x1 * t4.w + x2 * t4.z; } }
        }
#pragma unroll
        for (int ks = 0; ks < KS; ++ks) { u32x4 w; w.x = pk2(x[ks][0], x[ks][1]); w.y = pk2(x[ks][2], x[ks][3]); w.z = pk2(x[ks][4], x[ks][5]); w.w = pk2(x[ks][6], x[ks][7]); qf[ks] = __builtin_bit_cast(bf16x8, w); }
    }
    if (MODE != 0) __builtin_amdgcn_sched_barrier(0);
    if (MODE == 0 && nd.has) attn_dma64(lds0, nd.buf, wid, lane, nd.Kp, nd.Vp, nd.stride, nd.fv);
    f32x4 s[NKT];
    const LAS unsigned char* kb = lds + (kq * 256 + 16 * kt0 + qn) * 16;
#pragma unroll
    for (int i = 0; i < NKT; ++i) { s[i] = (f32x4){0.f, 0.f, 0.f, 0.f};
#pragma unroll
        for (int ks = 0; ks < KS; ++ks) { const bf16x8 kf = *(const LAS bf16x8*)(kb + (4 * ks * 256 + 16 * i) * 16); s[i] = __builtin_amdgcn_mfma_f32_16x16x32_bf16(kf, qf[ks], s[i], 0, 0, 0); }
        if (MODE != 0 && (i & 3) == 3) __builtin_amdgcn_sched_barrier(0); }
    if (MODE == 0) {
        const int qq = 16 * wid + qn;
#pragma unroll
        for (int i = 0; i < NKT; ++i)
#pragma unroll
            for (int e = 0; e < 4; ++e) { const int ki = 16 * (kt0 + i) + 4 * kq + e; const bool ok = (ki >= qq) && (ki <= qq + 128) && (ki >= first_valid); if (!ok) s[i][e] = -1e30f; }
    }
    float mx = -3.0e38f;
#pragma unroll
    for (int i = 0; i < NKT; ++i)
#pragma unroll
        for (int e = 0; e < 4; ++e) mx = fmaxf(mx, s[i][e]);
    mx = xmax4(mx);
    float l = 0.f;
#pragma unroll
    for (int i = 0; i < NKT; ++i)
#pragma unroll
        for (int e = 0; e < 4; ++e) { const float p = __builtin_amdgcn_exp2f(s[i][e] - mx); s[i][e] = p; l += p; }
    l = xsum4(l);
    bf16x8 pf[NG];
#pragma unroll
    for (int G = 0; G < NG; ++G) { u32x4 w; w.x = pk2(s[2 * G][0], s[2 * G][1]); w.y = pk2(s[2 * G][2], s[2 * G][3]);
        if (2 * G + 1 < NKT) { w.z = pk2(s[2 * G + 1][0], s[2 * G + 1][1]); w.w = pk2(s[2 * G + 1][2], s[2 * G + 1][3]); } else { w.z = 0u; w.w = 0u; }
        pf[G] = __builtin_bit_cast(bf16x8, w); }
    f32x4 o[DT];
#pragma unroll
    for (int dt = 0; dt < DT; ++dt) o[dt] = (f32x4){0.f, 0.f, 0.f, 0.f};
    const int q4 = qn >> 2, pp = qn & 3;
    const LAS unsigned char* vb = lds + 256 * HD * 2 + (16 * kt0 + 4 * kq + q4) * 32 + pp * 8;
#pragma unroll
    for (int G = 0; G < NG; ++G)
#pragma unroll
        for (int dt = 0; dt < DT; ++dt) {
            const int t1 = (2 * G + 1 < NKT) ? 2 * G + 1 : 2 * G;
            const s16x4 lo = __builtin_bit_cast(s16x4, __builtin_amdgcn_ds_read_tr16_b64_v4i16((LAS s16x4*)(vb + (dt * 256 + 32 * G) * 32)));
            const s16x4 hi = __builtin_bit_cast(s16x4, __builtin_amdgcn_ds_read_tr16_b64_v4i16((LAS s16x4*)(vb + (dt * 256 + 16 * t1) * 32)));
            const bf16x8 vf = (bf16x8){lo[0], lo[1], lo[2], lo[3], hi[0], hi[1], hi[2], hi[3]};
            o[dt] = __builtin_amdgcn_mfma_f32_16x16x32_bf16(pf[G], vf, o[dt], 0, 0, 0);
        }
    float linv[4];
#pragma unroll
    for (int e = 0; e < 4; ++e) linv[e] = 1.0f / shi(l, 4 * kq + e, lane);
#pragma unroll
    for (int e = 0; e < 4; ++e) { bf16_t* orow = Op + (long)(16 * wid + 4 * kq + e) * o_rstride + qn;
#pragma unroll
        for (int dt = 0; dt < DT; ++dt) orow[16 * dt] = (bf16_t)(pk2(o[dt][e] * linv[e], 0.f) & 0xffffu); }
    if (MODE == 0 && kq == 0) lsep[(long)(16 * wid + qn) * lse_stride] = (mx + __builtin_amdgcn_logf(l)) * LN2;
}


struct Args { const void* in[32]; float* out; unsigned char* ws; int lo, hi, mask, pad; };
enum { MSK_ATT = 1, MSK_MEM = 2, MSK_SSM = 4, MSK_FFN = 8, MSK_MOE = 16 };
constexpr int ST_LAYER0 = 4, ST_PER_LAYER = 16, ST_END = ST_LAYER0 + 2 * ST_PER_LAYER;

__global__ void __launch_bounds__(NWAVES * 64, 2) mega(Args args) {
    extern __shared__ __attribute__((aligned(16))) unsigned char lds_raw[];
    LAS unsigned char* lds = (LAS unsigned char*)lds_raw;
    const int tid0 = threadIdx.x; const int wave0 = __builtin_amdgcn_readfirstlane(tid0 >> 6);
    const int G0 = gridDim.x, bx0 = blockIdx.x, vcu0 = (G0 % 8 == 0) ? (bx0 % 8) * (G0 / 8) + bx0 / 8 : bx0, mask0 = args.mask;
    for (int u = tid0; u < (LDS_BYTES - LDSCTL_OFF) / 4; u += NWAVES * 64) ((LAS unsigned*)(lds + LDSCTL_OFF))[u] = 0u;
    if (tid0 == 0) {
#pragma unroll
        for (int k = 0; k < 32; ++k) *(volatile LAS unsigned long long*)(lds + LDSPTR_OFF + 8 * k) = (unsigned long long)args.in[k];
        *(volatile LAS unsigned long long*)(lds + LDSPTR_OFF + 8 * 32) = (unsigned long long)args.out;
        *(volatile LAS unsigned long long*)(lds + LDSPTR_OFF + 8 * 33) = (unsigned long long)args.ws;
    }
    __syncthreads();
    (void)xcd_barrier_post((unsigned*)(args.ws + WS_CTL) + 4096, (volatile LAS unsigned*)(lds + LDSCTL_OFF + 64));

    int dry = 0, reps = 0;
    for (int st = args.lo; st < args.hi; ++st) {
        int Gi = G0, vcu = vcu0, bx = bx0, mask = mask0; asm volatile("" : "+s"(Gi), "+s"(vcu), "+s"(bx), "+s"(mask));
        const int G = Gi, NGW = Gi * NWAVES;
        const int lane = lane_id_l(), wave = wave0, tid = wave0 * 64 + lane;
        const int gw = vcu * NWAVES + wave;
        LAS float* wscr = (LAS float*)(lds + wave * 16384);
        unsigned char* ws = lds_ptr<unsigned char>(lds, 33);
        float* ROPE = (float*)(ws + WS_ROPE);
        bf16_t* HN = (bf16_t*)(ws + WS_A); bf16_t* Yb = (bf16_t*)(ws + WS_A); bf16_t* H2 = (bf16_t*)(ws + WS_A); bf16_t* XS = (bf16_t*)(ws + WS_XS);
        bf16_t* QKV = (bf16_t*)(ws + WS_B); bf16_t* MERGED = (bf16_t*)(ws + WS_B + 16 * MiB); bf16_t* CAT = (bf16_t*)(ws + WS_CAT);
        bf16_t* XQ = (bf16_t*)(ws + WS_C); bf16_t* Gt = (bf16_t*)(ws + WS_D); bf16_t* HID = (bf16_t*)(ws + WS_D); bf16_t* Ut = (bf16_t*)(ws + WS_E);
        bf16_t* OG = (bf16_t*)(ws + WS_F); float* LSE = (float*)(ws + WS_F + 24 * MiB);
        bf16_t* SSMW = (bf16_t*)(ws + WS_SSMW);
        int* mt_nt = (int*)(ws + WS_META + MT_NT); int* mt_texp = (int*)(ws + WS_META + MT_TEXP); int* mt_toke = (int*)(ws + WS_META + MT_TOKE);
        float* mt_tokw = (float*)(ws + WS_META + MT_TOKW); int* mt_pos = (int*)(ws + WS_META + MT_POS); float* mt_roww = (float*)(ws + WS_META + MT_ROWW);
        bf16_t* MOEW = (bf16_t*)(ws + WS_MOEW); bf16_t* MOEWD = (bf16_t*)(ws + WS_MOEWD); bf16_t* MOEH = (bf16_t*)(ws + WS_MOEH); bf16_t* MOEA = (bf16_t*)(ws + WS_MOEA);

        bool do_gemm = false, do_bar = true, do_fp8 = false, post_expand = false;
        Gemm gm; Sched S; Epi E;
        gm.A = nullptr; gm.Bt = nullptr; gm.lda = 0; gm.ldb = 0; gm.K = 0;
        S.mode = 0; S.nM = 0; S.nN = 0; S.nwg = 0; S.G = G; S.c = bx; S.pn0 = 0; S.nfull = 0; S.texp = mt_texp; S.texl = (LAS const int*)(lds + LDSCTL_OFF + 1024);
        E.mode = EP_BF16; E.perm = 1; E.after_drain = 0; E.o0 = nullptr; E.o1 = nullptr; E.o2 = nullptr; E.o3 = nullptr; E.ldo = 0; E.gt = nullptr; E.fo = nullptr; E.fr = nullptr; E.ptab = nullptr; E.x8 = nullptr; E.xb = nullptr; E.ssq = nullptr; E.ssqr = nullptr;
        const int l = (st >= ST_LAYER0 + ST_PER_LAYER) ? 1 : 0;
        const int ls = (st >= ST_LAYER0) ? (st - ST_LAYER0 - l * ST_PER_LAYER) : -1;
        { unsigned lo_ = LDSCTL_OFF + 256 + 4 * wave; asm volatile("" : "+s"(lo_)); *(volatile LAS int*)(lds + lo_) = l; }
        bf16_t* WL = (bf16_t*)(ws + WS_WL + (size_t)l * WL_STRIDE);
        float* Ptab_l = (float*)(ws + WS_SSMT + (size_t)l * 4 * MiB); float* Ktab_l = (float*)(ws + WS_SSMT + (size_t)l * 4 * MiB + 2 * MiB);
        bf16_t* Winp_l = (bf16_t*)(ws + WS_WINP + (size_t)l * 16 * MiB);
        bf16_t* KVM_l = (bf16_t*)(ws + WS_KVM + (size_t)l * 2 * MiB);

        if (st == 0) {
            { const float* a_re = INF(5); const float* a_im = INF(6); const float* log_dt = INF(7); const float* b_re = INF(8); const float* b_im = INF(9); const float* c_re = INF(10); const float* c_im = INF(11);
            for (int it = gw; it < 2 * 32 * 33; it += NGW) { const int ll = it / (32 * 33), r = it % (32 * 33), g = r / 33, tau = r % 33;
                ssm_table_wave(lds + wave * 16384, lane, g, tau, a_re + ll * 2048, a_im + ll * 2048, log_dt + ll * 32, b_re + ll * 32768, b_im + ll * 32768, c_re + ll * 32768, c_im + ll * 32768,
                               (float*)(ws + WS_SSMT + (size_t)ll * 4 * MiB), (float*)(ws + WS_SSMT + (size_t)ll * 4 * MiB + 2 * MiB), (bf16_t*)(ws + WS_WINP + (size_t)ll * 16 * MiB)); } }
            {
                constexpr int PER_L = 5120, NIT = 2 * PER_L + 3 * 1408;
                const float* w_in = INF(4); const float* w_glu = INF(13); const float* w_ssm_out = INF(14); const float* w_att_out = INF(17); const float* w_mem_kv = INF(19); const float* w_mem_out = INF(22); const float* w_o = INF(23);
                const float* ffn_g = INF(25); const float* ffn_u = INF(26); const float* ffn_d = INF(27);
                const float* nm1 = INF(3) + DM; const float* nf0 = INF(24);
                const int gse0 = sample_sexp(w_in, lane), gse1 = sample_sexp(w_in + (size_t)DM * INC, lane); const float gsc0 = __builtin_amdgcn_exp2f((float)gse0), gsc1 = __builtin_amdgcn_exp2f((float)gse1);
                const int wose = sample_sexp(w_o + (size_t)DM * DM, lane); const float wosc = __builtin_amdgcn_exp2f((float)wose);
                if (gw == 0 && lane == 0) { int* se = (int*)(ws + WS_META + MT_SEXP); float* si = (float*)(ws + WS_META + MT_SINV); se[27] = gse0; se[28] = gse1; si[27] = __builtin_amdgcn_exp2f(-(float)gse0); si[28] = __builtin_amdgcn_exp2f(-(float)gse1); se[29] = wose; si[29] = __builtin_amdgcn_exp2f(-(float)wose); }
#define TR_DECODE0(it_, d) do { int r = (it_); \
                    if (r < 2 * PER_L) { const int ll = r / PER_L; r %= PER_L; bf16_t* W = (bf16_t*)(ws + WS_WL + (size_t)ll * WL_STRIDE); \
                        if (r < 3200) { trd_plain(d, w_in + (size_t)ll * DM * INC, INC, W + WL_IN / 2, DM, r, ll ? nm1 : nullptr, 0, 1.f); \
                            if (r % 200 >= 104) { d.q = 1; d.scale = ll ? gsc1 : gsc0; d.dst = (unsigned char*)W + WL_IN + (size_t)3328 * DM * (ll ? 1 : 2); d.drow0 -= 3328; } \
                            else { if (r % 200 >= 16 && r % 200 < 64) { const int c0_ = 32 * (r % 200), w_ = c0_ & 255; d.drow0 = (c0_ & ~255) + 128 * ((w_ >> 5) & 1) + 32 * (w_ >> 6); } \
                                if (ll) { d.q = 1; d.scale = gsc1; d.dst = (unsigned char*)W + WL_IN; } } break; } r -= 3200; \
                        if (r < 256) { const int half = r >= 128; trd_pair(d, w_glu + (size_t)ll * 512 * 1024, 512, 1024, half * 512, 512, W + WL_GLU / 2, half, r & 127, nullptr, 0, 1.f); break; } r -= 256; \
                        if (r < 256) { trd_plain(d, w_ssm_out + (size_t)ll * 512 * DM, DM, W + WL_CAT / 2, 1280, r, nullptr, 0, 1.f); break; } r -= 256; \
                        if (r < 128) { trd_plain(d, w_att_out + (size_t)ll * 256 * DM, DM, W + WL_CAT / 2 + 512, 1280, r, nullptr, 0, 1.f); break; } r -= 128; \
                        if (r < 512) { trd_plain(d, w_mem_kv + (size_t)ll * DM * 1024, 1024, W + WL_MKV / 2, DM, r, nullptr, 0, 1.f); break; } r -= 512; \
                        if (r < 256) { trd_plain(d, w_mem_out + (size_t)ll * 512 * DM, DM, W + WL_CAT / 2 + 768, 1280, r, nullptr, 0, 1.f); break; } r -= 256; \
                        trd_plain(d, w_o + (size_t)ll * DM * DM, DM, W + WL_WO / 2, DM, r, nullptr, ll, wosc); break; } \
                    r -= 2 * PER_L; \
                    if (r < 1408) { trd_pair(d, ffn_g, DM, DFF, 0, DFF, ws + WS_FFN, 0, r, nf0, 0, 1.f); break; } r -= 1408; \
                    if (r < 1408) { trd_pair(d, ffn_u, DM, DFF, 0, DFF, ws + WS_FFN, 1, r, nf0, 0, 1.f); break; } r -= 1408; \
                    trd_plain(d, ffn_d, DM, ws + WS_FFND, DFF, r, nullptr, 0, 1.f); } while (0)
                TrDesc d0{}, d1{}; f32x4 va[8], vb[8];
#pragma unroll
                for (int i = 0; i < 8; ++i) { va[i] = (f32x4){0.f, 0.f, 0.f, 0.f}; vb[i] = va[i]; }
                if (gw < NIT) { TR_DECODE0(gw, d0); trd_load(d0, va, lane); }
                for (int it = gw; it < NIT; it += NGW) {
                    const bool has = it + NGW < NIT;
                    if (has) { TR_DECODE0(it + NGW, d1); trd_load(d1, vb, lane); }
                    trd_finish(d0, va, wscr, lane);
                    if (has) { d0 = d1;
#pragma unroll
                        for (int i = 0; i < 8; ++i) va[i] = vb[i]; }
                }
            }
            { const float* x_in = INF(0); const float* mem = INF(1); const float* norm_mix = INF(3); const float* norm_mem = INF(18);
            for (int m = NT + gw; m < NT + 2048; m += NGW) { f32x4 v[4];
                const int mm = m - NT, ll = mm >> 10, rr = mm & 1023; rms_row(mem + (size_t)rr * DM, norm_mem + ll * DM, (bf16_t*)(ws + WS_MEMN + (size_t)ll * 2 * MiB) + (size_t)rr * DM, lane, v); }
            {
                f32x4 gx[4], nx[4];
#pragma unroll
                for (int j = 0; j < 4; ++j) { gx[j] = ((const f32x4*)norm_mix + lane)[64 * j]; nx[j] = (f32x4){0.f, 0.f, 0.f, 0.f}; }
                if (gw < NT) {
#pragma unroll
                    for (int j = 0; j < 4; ++j) nx[j] = __builtin_nontemporal_load((const f32x4*)(x_in + (size_t)gw * DM) + lane + 64 * j); }
                for (int m = gw; m < NT; m += NGW) { f32x4 cx[4];
#pragma unroll
                    for (int j = 0; j < 4; ++j) cx[j] = nx[j];
                    if (m + NGW < NT) {
#pragma unroll
                        for (int j = 0; j < 4; ++j) nx[j] = __builtin_nontemporal_load((const f32x4*)(x_in + (size_t)(m + NGW) * DM) + lane + 64 * j); }
                    rms_row_pre(cx, gx, HN + (size_t)m * DM, lane, ws + WS_X8 + (size_t)m * DM); } } }
            { const int* pos = lds_ptr<const int>(lds, 2);
            for (int m = gw; m < NT; m += NGW) { if (lane < 32) { const float inv = exp2f(-(float)lane * (13.287712379549449f / 32.f)); const float ang = (float)pos[m] * inv; float sn, cs; sincosf(ang, &sn, &cs);
                    *(f32x2*)(ROPE + (size_t)m * 64 + 2 * lane) = (f32x2){cs, sn}; } } }
            for (int z = gw; z < 8192; z += NGW) { const int ll = z >> 12, g = (z >> 7) & 31, r = 128 + (z & 127);
                bf16_t* p = (bf16_t*)(ws + WS_WINP + (size_t)ll * 16 * MiB) + ((size_t)(g * 256 + r)) * 512 + lane * 8;
                unsigned zz = 0u; asm volatile("" : "+v"(zz)); *(u32x4*)p = (u32x4){zz, zz, zz, zz}; }
        } else if (st == 1) {
            {
                const float* c_re = INF(10); const float* c_im = INF(11); const float* ssm_d = INF(12);
                const int w0 = gw, nw = NGW;
                for (int rr = w0; rr < 16384; rr += nw) ssm_expand_row(rr, lane, (const float*)(ws + WS_SSMT), (const float*)(ws + WS_SSMT + 2 * MiB), c_re, c_im, ssm_d, SSMW); }
            do_bar = false;
        } else if (st == 2 || st == 3) {
            do_bar = false;
        } else if (ls == 0 || ls == 3) {
            gm.A = (l == 0) ? HN : (const bf16_t*)(ws + WS_X8); gm.Bt = WL + WL_IN / 2; gm.lda = DM; gm.ldb = DM; gm.K = DM; do_fp8 = (l == 1);
            const bool split = (G == 256);
            if (ls == 0) { S.mode = 0; S.nM = NT / 256; S.nN = split ? 12 : 13; S.nwg = S.nM * S.nN; }
            else { S.mode = 0; S.nM = NT / 256; S.nN = 1; S.nwg = split ? 64 : 0; S.pn0 = 12; S.c = (bx + G - 64) % G; }
            E.mode = EP_INPROJ; E.o0 = Ut; E.o1 = QKV; E.o2 = XQ; E.o3 = Gt; if (l == 1) E.ssqr = (const float*)(ws + WS_SSQ);
            do_gemm = true; do_bar = false;
        } else if (ls == 1) {
            gm.A = (const bf16_t*)(ws + WS_X8); gm.Bt = (const bf16_t*)((unsigned char*)WL + WL_IN + (size_t)3328 * DM * (l ? 1 : 2)); gm.lda = DM; gm.ldb = DM; gm.K = DM;
            S.mode = 0; S.nM = NT / 256; S.nN = 12; S.nwg = S.nM * 12;
            E.mode = EP_GATEQ; E.o3 = Gt; if (l == 1) E.ssqr = (const float*)(ws + WS_SSQ);
            do_gemm = true; do_fp8 = true;
        } else if (ls == 2) {
            if (mask & MSK_SSM) {
                gm.A = Ut; gm.Bt = Winp_l; gm.lda = 640; gm.ldb = 512; gm.K = 512;
                S.mode = 5; S.nM = 64; S.nN = 1; S.nwg = 64;
                E.mode = EP_ZSCAN; E.perm = 0; E.after_drain = 1; E.o0 = Ut; E.ptab = Ptab_l;
                do_gemm = true; }
            do_bar = false;
        } else if (ls == 4 || ls == 6) {
            const int r = vcu & 31, grp = vcu >> 5;
            if (mask & MSK_ATT) {
                const float* att_qn = INF(15); const float* att_kn = INF(16);
                int u0, u1;
                if (G == 256) {
                    if (l == 0) {
                        if (ls == 4) { u0 = grp * 132 + (r < 8 ? 3 * r : (r < 16 ? 24 + (r - 8) : (r < 20 ? 32 + (r - 16) : 36 + 8 * (r - 20)))); u1 = u0 + (r < 8 ? 3 : (r < 20 ? 1 : 8)); }
                        else { u0 = 1056 + grp * 60 + (r < 20 ? 2 * r : (r < 28 ? 40 + 2 * (r - 20) : 56 + (r - 28))); u1 = u0 + (r < 28 ? 2 : 1); }
                    } else {
                        if (ls == 4) { u0 = grp * 160 + (r < 16 ? 3 * r : 48 + 7 * (r - 16)); u1 = u0 + (r < 16 ? 3 : 7); }
                        else { u0 = 1280 + grp * 32 + r; u1 = u0 + 1; } }
                } else { const int per = (1536 + G - 1) / G; u0 = (ls == 4) ? vcu * per : 1536; u1 = (ls == 4) ? ((u0 + per < 1536) ? u0 + per : 1536) : 1536; }
#define DIL_DECODE(uid_, h, g, d, tok0, tokk, fv) const int b_ = (uid_) / 384, rem_ = (uid_) % 384, h = rem_ >> 5, blk_ = rem_ & 31, g = h >> 2, d = 1 << (2 * g), nbpr_ = 32 >> (2 * g), rr_ = blk_ / nbpr_, nb_ = blk_ % nbpr_; \
                    const long tok0 = (long)b_ * SEQ + (long)nb_ * 128 * d + rr_, tokk = tok0 - (long)128 * d; const int fv = (nb_ == 0) ? 128 : 0
                __syncthreads();
                u32x4 qn0 = (u32x4){0u, 0u, 0u, 0u}, qn1 = qn0;
                if (u0 < u1) { DIL_DECODE(u0, h, g, d, tok0, tokk, fv); attn_dma64(lds, 0, wave, lane, QKV + tokk * 2304 + 768 + h * 64, QKV + tokk * 2304 + 1536 + h * 64, (long)d * 2304, fv);
                    const bf16_t* qrow = QKV + tok0 * 2304 + h * 64 + (long)(16 * wave + (lane & 15)) * ((long)d * 2304) + 8 * (lane >> 4); qn0 = *(const u32x4*)qrow; qn1 = *(const u32x4*)(qrow + 32); }
                for (int uid = u0; uid < u1; ++uid) {
                    DIL_DECODE(uid, h, g, d, tok0, tokk, fv);
                    NextDma nd; nd.has = (uid + 1 < u1) ? 1 : 0; nd.buf = ((uid + 1 - u0) & 1) * 65536; nd.fv = 0; nd.Kp = nullptr; nd.Vp = nullptr; nd.stride = 0;
                    if (nd.has) { DIL_DECODE(uid + 1, h2, g2, d2, tok02, tokk2, fv2); (void)g2; (void)tok02; nd.fv = fv2; nd.Kp = QKV + tokk2 * 2304 + 768 + h2 * 64; nd.Vp = QKV + tokk2 * 2304 + 1536 + h2 * 64; nd.stride = (long)d2 * 2304; }
                    asm volatile("s_waitcnt vmcnt(0)" ::: "memory"); __syncthreads();
                    u32x4 qc0 = qn0, qc1 = qn1; asm volatile("" : "+v"(qc0), "+v"(qc1));
                    if (nd.has) { DIL_DECODE(uid + 1, h3, g3, d3, tok03, tokk3, fv3); (void)g3; (void)tokk3; (void)fv3;
                        const bf16_t* qrow = QKV + tok03 * 2304 + h3 * 64 + (long)(16 * wave + (lane & 15)) * ((long)d3 * 2304) + 8 * (lane >> 4); qn0 = *(const u32x4*)qrow; qn1 = *(const u32x4*)(qrow + 32); }
                    attn_compute<64, 0>(lds + ((uid - u0) & 1) * 65536, wave, lane, QKV + tok0 * 2304 + h * 64, (long)d * 2304, nullptr, nullptr, 0, fv,
                                        OG + ((long)g * NT + tok0) * 256 + (h & 3) * 64, (long)d * 256, LSE + ((long)g * NT + tok0) * 4 + (h & 3), (long)d * 4, lds, nd, qc0, qc1);
                }
                asm volatile("s_waitcnt vmcnt(0)" ::: "memory");
#undef DIL_DECODE
            }
            if (ls == 6 && (mask & MSK_MEM)) {
                const float* mem_qn = INF(20); const float* mem_kn = INF(21);
                int m0 = vcu, m1 = 256, ms = G;
                if (G == 256) { if (r >= 16) { m0 = 2 * (grp * 16 + (r - 16)); m1 = m0 + 2; } else { m0 = 0; m1 = 0; } ms = 1; }
                int staged = -1;
                for (int uid = m0; uid < m1; uid += ms) {
                    const int b = uid >> 6, h = (uid >> 4) & 3, qb = uid & 15; const int lnl = lane_id_l(), tidl = wave * 64 + lnl;
                    const bf16_t* Kp = KVM_l + ((size_t)b * 256) * 1024 + h * 128;
                    if (staged != (uid >> 4)) {
                        __syncthreads();
                        attn_stage<128, 1>(lds, tidl, Kp, Kp + 512, 1024, 0, mem_kn + l * 128, nullptr, 0);
                        __syncthreads(); staged = uid >> 4; }
                    for (int qs = 0; qs < 2; ++qs) { const long tok0 = (long)b * SEQ + qb * 256 + qs * 128;
                        attn_compute<128, 1>(lds, wave, lnl, XQ + tok0 * 512 + h * 128, 512, mem_qn + l * 128, nullptr, 0, 0, CAT + tok0 * 1280 + 768 + h * 128, 1280, nullptr, 0); }
                }
            }
            __syncthreads();
            if (l == 0 && ls == 4) {
                gm.A = (const bf16_t*)(ws + WS_MEMN); gm.Bt = (const bf16_t*)(ws + WS_WL + WL_MKV); gm.lda = DM; gm.ldb = DM; gm.K = DM;
                S.mode = 3; S.nM = 8; S.nN = 4; S.nwg = 32; if (G == 256) S.c = (bx + G - 128) % G;
                E.mode = EP_BF16; E.o0 = (bf16_t*)(ws + WS_KVM); E.ldo = 1024;
                do_gemm = true; }
        } else if (ls == 5) {
            if (mask & MSK_SSM) {
                gm.A = Ut; gm.Bt = SSMW; gm.lda = 640; gm.ldb = 640; gm.K = 640;
                S.mode = 5; S.nM = 64; S.nN = 2; S.nwg = 128;
                E.mode = EP_SSMOUT; E.o0 = Yb;
                do_gemm = true; }
            do_bar = false;
        } else if (ls == 7) {
            if (mask & MSK_ATT) {
                for (int idx = vcu * 512 + tid; idx < NT * 32; idx += G * 512) {
                    const int tok = idx >> 5, ch = idx & 31, slot = ch >> 3;
                    const float l0 = LSE[((size_t)0 * NT + tok) * 4 + slot], l1 = LSE[((size_t)1 * NT + tok) * 4 + slot], l2 = LSE[((size_t)2 * NT + tok) * 4 + slot];
                    const float m = fmaxf(fmaxf(l0, l1), l2); float e0 = __expf(l0 - m), e1 = __expf(l1 - m), e2 = __expf(l2 - m); const float inv = 1.f / (e0 + e1 + e2); e0 *= inv; e1 *= inv; e2 *= inv;
                    const u32x4 v0 = __builtin_nontemporal_load((const u32x4*)(OG + ((size_t)0 * NT + tok) * 256 + ch * 8)), v1 = __builtin_nontemporal_load((const u32x4*)(OG + ((size_t)1 * NT + tok) * 256 + ch * 8)), v2 = __builtin_nontemporal_load((const u32x4*)(OG + ((size_t)2 * NT + tok) * 256 + ch * 8));
                    u32x4 w;
                    w.x = pk2(e0 * bflo(v0.x) + e1 * bflo(v1.x) + e2 * bflo(v2.x), e0 * bfhi(v0.x) + e1 * bfhi(v1.x) + e2 * bfhi(v2.x));
                    w.y = pk2(e0 * bflo(v0.y) + e1 * bflo(v1.y) + e2 * bflo(v2.y), e0 * bfhi(v0.y) + e1 * bfhi(v1.y) + e2 * bfhi(v2.y));
                    w.z = pk2(e0 * bflo(v0.z) + e1 * bflo(v1.z) + e2 * bflo(v2.z), e0 * bfhi(v0.z) + e1 * bfhi(v1.z) + e2 * bfhi(v2.z));
                    w.w = pk2(e0 * bflo(v0.w) + e1 * bflo(v1.w) + e2 * bflo(v2.w), e0 * bfhi(v0.w) + e1 * bfhi(v1.w) + e2 * bfhi(v2.w));
                    *(u32x4*)(CAT + (size_t)tok * 1280 + 512 + ch * 8) = w;
                }
            }
            if (mask & MSK_SSM) {
                gm.A = Yb; gm.Bt = WL + WL_GLU / 2; gm.lda = 512; gm.ldb = 512; gm.K = 512;
                S.mode = 0; S.nM = NT / 256; S.nN = 4; S.nwg = 256;
                E.mode = EP_GLU; E.o0 = CAT; E.ldo = 1280;
                do_gemm = true; }
        } else if (ls == 8) {
            gm.A = CAT; gm.Bt = WL + WL_CAT / 2; gm.lda = 1280; gm.ldb = 1280; gm.K = 1280;
            S.mode = 0; S.nM = NT / 256; S.nN = 4; S.nwg = 256;
            E.mode = EP_MERGEF; E.o0 = MERGED; E.gt = Gt; if (l == 1) E.x8 = (unsigned char*)MERGED;
            do_gemm = true;
        } else if (ls == 9) {
            gm.A = MERGED; gm.Bt = WL + WL_WO / 2; gm.lda = DM; gm.ldb = DM; gm.K = DM; do_fp8 = (l == 1);
            S.mode = 0; S.nM = NT / 256; S.nN = 4; S.nwg = 256;
            E.mode = EP_RESID; E.fr = (l == 0) ? INF(0) : nullptr; E.xb = XS; E.ssq = (float*)(ws + WS_SSQ);
            do_gemm = true;
        } else if (ls == 10) {
            float* out = lds_ptr<float>(lds, 32); const float* norm_ffn = INF(24); const float* moe_r = INF(28);
            if (l == 0) do_bar = false;
            else {
                f32x4 wr0[16], wr1[16];
#pragma unroll
                for (int j = 0; j < 4; ++j)
#pragma unroll
                    for (int i = 0; i < 4; ++i) { const int k = 8 * lane + 512 * (j >> 1) + 4 * (j & 1) + i; wr0[4 * j + i] = *(const f32x4*)(moe_r + k * 8); wr1[4 * j + i] = *(const f32x4*)(moe_r + k * 8 + 4); }
                f32x4 gn[4];
#pragma unroll
                for (int j = 0; j < 2; ++j) { gn[2 * j] = *(const f32x4*)(norm_ffn + l * DM + 8 * lane + 512 * j); gn[2 * j + 1] = *(const f32x4*)(norm_ffn + l * DM + 8 * lane + 512 * j + 4); }
                u32x4 nx0 = (u32x4){0u, 0u, 0u, 0u}, nx1 = nx0;
                if (gw < NT) { const u32x4* xr = (const u32x4*)(XS + (size_t)gw * DM) + lane; nx0 = __builtin_nontemporal_load(xr); nx1 = __builtin_nontemporal_load(xr + 64); }
                for (int m = gw; m < NT; m += NGW) { f32x4 v[4]; const u32x4 cx0 = nx0, cx1 = nx1;
                    if (m + NGW < NT) { const u32x4* xr = (const u32x4*)(XS + (size_t)(m + NGW) * DM) + lane; nx0 = __builtin_nontemporal_load(xr); nx1 = __builtin_nontemporal_load(xr + 64); }
                    rms_row_b_pre(cx0, cx1, gn, H2 + (size_t)m * DM, lane, v);
                    float lg[8];
#pragma unroll
                    for (int e = 0; e < 8; ++e) lg[e] = 0.f;
#pragma unroll
                    for (int j = 0; j < 4; ++j)
#pragma unroll
                        for (int i = 0; i < 4; ++i) { const f32x4 w0 = wr0[4 * j + i], w1 = wr1[4 * j + i]; const float h = v[j][i];
                            lg[0] += h * w0.x; lg[1] += h * w0.y; lg[2] += h * w0.z; lg[3] += h * w0.w; lg[4] += h * w1.x; lg[5] += h * w1.y; lg[6] += h * w1.z; lg[7] += h * w1.w; }
                    float a4[4];
#pragma unroll
                    for (int e = 0; e < 4; ++e) { const u2v r = __builtin_amdgcn_permlane32_swap(__float_as_uint(lg[e]), __float_as_uint(lg[4 + e]), false, false); a4[e] = __uint_as_float(r.x) + __uint_as_float(r.y); }
                    float a2[2];
#pragma unroll
                    for (int e = 0; e < 2; ++e) { const u2v r = __builtin_amdgcn_permlane16_swap(__float_as_uint(a4[e]), __float_as_uint(a4[2 + e]), false, false); a2[e] = __uint_as_float(r.x) + __uint_as_float(r.y); }
                    float a1; { const float keep = (lane & 8) ? a2[1] : a2[0], send = (lane & 8) ? a2[0] : a2[1]; a1 = keep + dppf<0x128>(send); }
                    a1 += dppf<0xB1>(a1); a1 += dppf<0x4E>(a1); a1 += dppf<0x141>(a1);
#pragma unroll
                    for (int e = 0; e < 8; ++e) lg[e] = shi(a1, 8 * e, lane);
                    int i0 = 0; float v0 = lg[0];
#pragma unroll
                    for (int e = 1; e < 8; ++e) if (lg[e] > v0) { v0 = lg[e]; i0 = e; }
                    int i1 = 0; float v1 = -3.4e38f;
#pragma unroll
                    for (int e = 0; e < 8; ++e) if (e != i0 && lg[e] > v1) { v1 = lg[e]; i1 = e; }
                    const float e1 = __expf(v1 - v0);
                    if (lane == 0) { mt_toke[m] = i0 | (i1 << 8); *(f32x2*)(mt_tokw + 2 * m) = (f32x2){1.f / (1.f + e1), e1 / (1.f + e1)}; }
                } }
            asm volatile("" ::: "memory");
            if (l == 1 && gw < 24) {
                const float* Wm = (gw >= 16) ? INF(31) + (size_t)(gw - 16) * DFE * DM : ((gw & 1) ? INF(30) : INF(29)) + (size_t)(gw >> 1) * DM * DFE; const int ldw = (gw >= 16) ? DM : DFE; float ss = 0.f;
                f32x4 w16[16];
#pragma unroll
                for (int k = 0; k < 16; ++k) w16[k] = *(const f32x4*)(Wm + (size_t)k * ldw + 4 * lane);
                __builtin_amdgcn_sched_barrier(0);
#pragma unroll
                for (int k = 0; k < 16; ++k) ss += (w16[k].x * w16[k].x + w16[k].y * w16[k].y) + (w16[k].z * w16[k].z + w16[k].w * w16[k].w);
                ss = wave_sum(ss, lane); const float rms = sqrtf(ss * (1.f / 4096.f));
                int se = 3 - (int)rintf(__builtin_amdgcn_logf(fmaxf(rms, 1e-30f))); se = se < -100 ? -100 : (se > 100 ? 100 : se);
                if (lane == 0) { ((int*)(ws + WS_META + MT_SEXP))[gw] = se; ((float*)(ws + WS_META + MT_SINV))[gw] = __builtin_amdgcn_exp2f(-(float)se); } }
        } else if (l == 0 && ls == 11) {
            if (mask & MSK_FFN) {
                gm.A = XS; gm.Bt = (const bf16_t*)(ws + WS_FFN); gm.lda = DM; gm.ldb = DM; gm.K = DM;
                S.mode = 0; S.nM = NT / 256; S.nN = 22; S.nwg = S.nM * S.nN;
                E.mode = EP_SWIGLU; E.o0 = HID; E.ldo = DFF; E.ssqr = (const float*)(ws + WS_SSQ);
                do_gemm = true; }
            post_expand = true;
        } else if (l == 0 && ls == 12) {
            if (mask & MSK_FFN) {
                gm.A = HID; gm.Bt = (const bf16_t*)(ws + WS_FFND); gm.lda = DFF; gm.ldb = DFF; gm.K = DFF;
                S.mode = 0; S.nM = NT / 256; S.nN = 4; S.nwg = 256;
                E.mode = EP_RESID; E.fr = nullptr; E.xb = XS; E.ssq = (float*)(ws + WS_SSQ); E.x8 = ws + WS_X8;
                do_gemm = true; }
        } else if (l == 0 && ls >= 13) {
            do_bar = false;
        } else if (l == 1 && ls == 11) {
            if (mask & MSK_MOE) {
                if (vcu == 0) {
                    LAS int* cnt = (LAS int*)(lds + 131072 - 256); LAS int* base = cnt + 8; LAS int* fill = cnt + 16;
                    if (tid < 8) { cnt[tid] = 0; fill[tid] = 0; }
                    __syncthreads();
                    for (int tok = tid; tok < NT; tok += 512) { const int ee = mt_toke[tok]; __hip_atomic_fetch_add(cnt + (ee & 255), 1, __ATOMIC_RELAXED, __HIP_MEMORY_SCOPE_WORKGROUP); __hip_atomic_fetch_add(cnt + (ee >> 8), 1, __ATOMIC_RELAXED, __HIP_MEMORY_SCOPE_WORKGROUP); }
                    __syncthreads();
                    if (tid == 0) { int off = 0;
#pragma nounroll
                        for (int e = 0; e < 8; ++e) { base[e] = off; const int tiles = (cnt[e] + 255) >> 8;
#pragma nounroll
                            for (int j = 0; j < tiles; ++j) mt_texp[(off >> 8) + j] = e;
                            off += tiles * 256; }
                        __hip_atomic_store(mt_nt, off >> 8, __ATOMIC_RELAXED, __HIP_MEMORY_SCOPE_AGENT); }
                    __syncthreads();
                    for (int tok = tid; tok < NT; tok += 512) { const int ee = mt_toke[tok]; const int e0 = ee & 255, e1 = ee >> 8; const f32x2 w = *(const f32x2*)(mt_tokw + 2 * tok);
                        const int p0 = base[e0] + __hip_atomic_fetch_add(fill + e0, 1, __ATOMIC_RELAXED, __HIP_MEMORY_SCOPE_WORKGROUP);
                        const int p1 = base[e1] + __hip_atomic_fetch_add(fill + e1, 1, __ATOMIC_RELAXED, __HIP_MEMORY_SCOPE_WORKGROUP);
                        mt_pos[2 * tok] = p0; mt_pos[2 * tok + 1] = p1; mt_roww[p0] = w.x; mt_roww[p1] = w.y; }
                    __syncthreads();
                }
                const float* moe_g = INF(29); const float* moe_u = INF(30); const float* moe_d = INF(31);
                if (vcu != 0 || G == 1) {
                    const int* sx = (const int*)(ws + WS_META + MT_SEXP);
#define TR_DECODE1(it_, d) do { const int e = (it_) / 5376; int r = (it_) % 5376; \
                        if (r < 1792) { trd_pair(d, moe_g + (size_t)e * DM * DFE, DM, DFE, 0, DFE, (unsigned char*)MOEW + (size_t)e * 7168 * DM, 0, r, nullptr, 1, __builtin_amdgcn_exp2f((float)sx[2 * e])); break; } r -= 1792; \
                        if (r < 1792) { trd_pair(d, moe_u + (size_t)e * DM * DFE, DM, DFE, 0, DFE, (unsigned char*)MOEW + (size_t)e * 7168 * DM, 1, r, nullptr, 1, __builtin_amdgcn_exp2f((float)sx[2 * e + 1])); break; } r -= 1792; \
                        trd_plain(d, moe_d + (size_t)e * DFE * DM, DM, (unsigned char*)MOEWD + (size_t)e * DM * DFE, DFE, r, nullptr, 1, __builtin_amdgcn_exp2f((float)sx[16 + e])); } while (0)
                    const int it0 = (G == 1) ? gw : gw - NWAVES, itn = (G == 1) ? NGW : NGW - NWAVES, NITM = 8 * 5376;
                    TrDesc d0{}, d1{}; f32x4 va[8], vb[8];
#pragma unroll
                for (int i = 0; i < 8; ++i) { va[i] = (f32x4){0.f, 0.f, 0.f, 0.f}; vb[i] = va[i]; }
                    if (it0 < NITM) { TR_DECODE1(it0, d0); trd_load(d0, va, lane); }
                    for (int it = it0; it < NITM; it += itn) {
                        const bool has = it + itn < NITM;
                        if (has) { TR_DECODE1(it + itn, d1); trd_load(d1, vb, lane); }
                        trd_finish(d0, va, wscr, lane);
                        if (has) { d0 = d1;
#pragma unroll
                            for (int i = 0; i < 8; ++i) va[i] = vb[i]; }
                    }
                }
            }
        } else if (l == 1 && ls == 12) {
            if (mask & MSK_MOE) {
                for (int m = gw; m < NT; m += NGW) { const int p0 = mt_pos[2 * m], p1 = mt_pos[2 * m + 1];
                    const u32x4* src = (const u32x4*)(H2 + (size_t)m * DM) + 2 * lane; const u32x4 a = __builtin_nontemporal_load(src), b = __builtin_nontemporal_load(src + 1);
                    float x[16] = {bflo(a.x), bfhi(a.x), bflo(a.y), bfhi(a.y), bflo(a.z), bfhi(a.z), bflo(a.w), bfhi(a.w), bflo(b.x), bfhi(b.x), bflo(b.y), bfhi(b.y), bflo(b.z), bfhi(b.z), bflo(b.w), bfhi(b.w)};
#pragma unroll
                    for (int e = 0; e < 16; ++e) x[e] = clamp448(16.f * x[e]);
                    u32x4 q; q.x = pk4_fp8(x[0], x[1], x[2], x[3]); q.y = pk4_fp8(x[4], x[5], x[6], x[7]); q.z = pk4_fp8(x[8], x[9], x[10], x[11]); q.w = pk4_fp8(x[12], x[13], x[14], x[15]);
                    *((u32x4*)((unsigned char*)MOEA + (size_t)p0 * DM) + lane) = q; *((u32x4*)((unsigned char*)MOEA + (size_t)p1 * DM) + lane) = q; }
            }
        } else if (l == 1 && ls == 13) {
            if (mask & MSK_MOE) {
                const int ntile = __builtin_amdgcn_readfirstlane(__hip_atomic_load(mt_nt, __ATOMIC_RELAXED, __HIP_MEMORY_SCOPE_AGENT));
                if (tid < 256) ((LAS int*)(lds + LDSCTL_OFF + 1024))[tid] = __hip_atomic_load(mt_texp + tid, __ATOMIC_RELAXED, __HIP_MEMORY_SCOPE_AGENT);
                __syncthreads();
                gm.A = MOEA; gm.Bt = MOEW; gm.lda = DM; gm.ldb = DM; gm.K = DM;
                S.mode = 2; S.nM = ntile; S.nN = 28; S.nwg = ntile * 28;
                E.mode = EP_SWIGLUQ; E.o0 = MOEH; E.ldo = DFE;
                do_gemm = true; do_fp8 = true; }
        } else if (l == 1 && ls == 14) {
            if (mask & MSK_MOE) {
                const int ntile = __builtin_amdgcn_readfirstlane(__hip_atomic_load(mt_nt, __ATOMIC_RELAXED, __HIP_MEMORY_SCOPE_AGENT));
                if (tid < 256) ((LAS int*)(lds + LDSCTL_OFF + 1024))[tid] = __hip_atomic_load(mt_texp + tid, __ATOMIC_RELAXED, __HIP_MEMORY_SCOPE_AGENT);
                __syncthreads();
                gm.A = MOEH; gm.Bt = MOEWD; gm.lda = DFE; gm.ldb = DFE; gm.K = DFE;
                const int nfull = ntile < 128 ? ntile : 128;
                S.mode = 4; S.nM = ntile; S.nN = 4; S.nfull = nfull; S.nwg = nfull * 4 + (ntile - nfull) * 16;
                E.mode = EP_MOEDOWNQ; E.o0 = MOEA; E.o1 = MOEW;
                do_gemm = true; do_fp8 = true; }
        } else if (l == 1 && ls == 15) {
            if (mask & MSK_MOE) {
                float* out = lds_ptr<float>(lds, 32);
                for (int m = gw; m < NT; m += 2 * NGW) {
                    const int m2 = (m + NGW < NT) ? m + NGW : m;
                    const int p0 = mt_pos[2 * m], p1 = mt_pos[2 * m + 1], q0 = mt_pos[2 * m2], q1 = mt_pos[2 * m2 + 1];
                    const u32x4* c0 = (const u32x4*)(MOEA + (size_t)p0 * DM) + lane; const u32x4* c1 = (const u32x4*)(MOEA + (size_t)p1 * DM) + lane;
                    const u32x4* d0 = (const u32x4*)(MOEA + (size_t)q0 * DM) + lane; const u32x4* d1 = (const u32x4*)(MOEA + (size_t)q1 * DM) + lane;
                    f32x4* xw = (f32x4*)(out + (size_t)m * DM) + 2 * lane; f32x4* yw = (f32x4*)(out + (size_t)m2 * DM) + 2 * lane;
                    const u32x4* xo = (const u32x4*)(XS + (size_t)m * DM) + lane; const u32x4* yo = (const u32x4*)(XS + (size_t)m2 * DM) + lane;
                    u32x4 ca[2], cb[2], da[2], db[2]; f32x4 x[4], y[4];
#pragma unroll
                    for (int j = 0; j < 2; ++j) { ca[j] = __builtin_nontemporal_load(c0 + 64 * j); cb[j] = __builtin_nontemporal_load(c1 + 64 * j); da[j] = __builtin_nontemporal_load(d0 + 64 * j); db[j] = __builtin_nontemporal_load(d1 + 64 * j); const u32x4 xr = __builtin_nontemporal_load(xo + 64 * j), yr = __builtin_nontemporal_load(yo + 64 * j);
                        x[2 * j] = (f32x4){0.f, 0.f, 0.f, 0.f}; x[2 * j + 1] = x[2 * j]; y[2 * j] = x[2 * j]; y[2 * j + 1] = x[2 * j];
                        if (p0 >= 32768 || p1 >= 32768 || q0 >= 32768 || q1 >= 32768) {
                            const int pp[4] = {p0, p1, q0, q1}; u32x4 tt[3][4];
#pragma unroll
                            for (int sl = 0; sl < 3; ++sl)
#pragma unroll
                                for (int k = 0; k < 4; ++k) tt[sl][k] = *((const u32x4*)(MOEW + (size_t)sl * 2048 * DM + (size_t)(pp[k] >= 32768 ? pp[k] - 32768 : 0) * DM) + lane + 64 * j);
#pragma unroll
                            for (int sl = 0; sl < 3; ++sl)
#pragma unroll
                                for (int k = 0; k < 4; ++k) { const float mk = pp[k] >= 32768 ? 1.f : 0.f; const u32x4 t = tt[sl][k];
                                    const f32x4 lo = (f32x4){bflo(t.x), bfhi(t.x), bflo(t.y), bfhi(t.y)} * mk, hi = (f32x4){bflo(t.z), bfhi(t.z), bflo(t.w), bfhi(t.w)} * mk;
                                    if (k < 2) { x[2 * j] += lo; x[2 * j + 1] += hi; } else { y[2 * j] += lo; y[2 * j + 1] += hi; } } }
                        x[2 * j] += (f32x4){bflo(xr.x), bfhi(xr.x), bflo(xr.y), bfhi(xr.y)}; x[2 * j + 1] += (f32x4){bflo(xr.z), bfhi(xr.z), bflo(xr.w), bfhi(xr.w)};
                        y[2 * j] += (f32x4){bflo(yr.x), bfhi(yr.x), bflo(yr.y), bfhi(yr.y)}; y[2 * j + 1] += (f32x4){bflo(yr.z), bfhi(yr.z), bflo(yr.w), bfhi(yr.w)}; }
#pragma unroll
                    for (int j = 0; j < 2; ++j) { const u32x4 a = ca[j], b = cb[j]; f32x4 x0 = x[2 * j], x1 = x[2 * j + 1];
                        x0.x += bflo(a.x) + bflo(b.x); x0.y += bfhi(a.x) + bfhi(b.x); x0.z += bflo(a.y) + bflo(b.y); x0.w += bfhi(a.y) + bfhi(b.y);
                        x1.x += bflo(a.z) + bflo(b.z); x1.y += bfhi(a.z) + bfhi(b.z); x1.z += bflo(a.w) + bflo(b.w); x1.w += bfhi(a.w) + bfhi(b.w);
                        __builtin_nontemporal_store(x0, xw + 128 * j); __builtin_nontemporal_store(x1, xw + 128 * j + 1); }
                    if (m2 != m) {
#pragma unroll
                        for (int j = 0; j < 2; ++j) { const u32x4 a = da[j], b = db[j]; f32x4 x0 = y[2 * j], x1 = y[2 * j + 1];
                            x0.x += bflo(a.x) + bflo(b.x); x0.y += bfhi(a.x) + bfhi(b.x); x0.z += bflo(a.y) + bflo(b.y); x0.w += bfhi(a.y) + bfhi(b.y);
                            x1.x += bflo(a.z) + bflo(b.z); x1.y += bfhi(a.z) + bfhi(b.z); x1.z += bflo(a.w) + bflo(b.w); x1.w += bfhi(a.w) + bfhi(b.w);
                            __builtin_nontemporal_store(x0, yw + 128 * j); __builtin_nontemporal_store(x1, yw + 128 * j + 1); } }
                }
            }
        }
        if (do_gemm) { if (do_fp8) gemm_phase<true>(lds, wave, gm, S, E); else gemm_phase<false>(lds, wave, gm, S, E); }
        if (post_expand) {
            const int nfree = (G == 256) ? 128 : G, b0 = (G == 256) ? 128 : 0;
            if (bx >= b0) { const float* c_re = INF(10); const float* c_im = INF(11); const float* ssm_d = INF(12);
                for (int rr = (bx - b0) * NWAVES + wave; rr < 16384; rr += nfree * NWAVES) ssm_expand_row(rr, lane, (const float*)(ws + WS_SSMT + 4 * MiB), (const float*)(ws + WS_SSMT + 6 * MiB), c_re + 32768, c_im + 32768, ssm_d + 512, SSMW); } }
        if (PROBE_HI > PROBE_LO && st == PROBE_HI - 1) { if (reps < PROBE_N) { ++reps; dry = 1; st = PROBE_LO - 1; do_bar = true; } else dry = 0; }
        if (do_bar && st + 1 < args.hi) { XcdBarrier bb; bb.bar = (unsigned*)(lds_ptr<unsigned char>(lds, 33) + WS_CTL) + 4096; bb.x = xb_xcc_id(); bb.st = (volatile LAS unsigned*)(lds + LDSCTL_OFF + 64); xcd_barrier(bb); }
    }
}
}

template <int MODE>
static void ngemm(hipStream_t st, const float* A, int lda, const float* B, int ldb, float* C, int ldc, int M, int N, int K, const float* aux = nullptr, int ldaux = 0) {
    hipLaunchKernelGGL((nv::k_gemm<MODE>), dim3(N / 128, M / 128), dim3(256), 0, st, A, lda, B, ldb, C, ldc, K, aux, ldaux);
}
static void cvt(hipStream_t st, const float* src, void* dst, size_t n, int cols, int ldd) { hipLaunchKernelGGL(nv::k_cvt_f2b, dim3((unsigned)((n + 255) / 256)), dim3(256), 0, st, src, (unsigned short*)dst, n, cols, ldd); }

extern "C" void kernel_launch(void* const* d_in, const int* in_sizes, int n_in, void* d_out, int out_size, void* d_ws, size_t ws_size, hipStream_t stream) {
    using namespace mk;
    static int grid = 0;
    if (grid == 0) {
        if (n_in != 32 || ws_size < WS_END) { fprintf(stderr, "kernel_launch: unexpected n_in %d / ws %zu\n", n_in, ws_size); grid = -1; return; }
        int dev = 0, cus = 0;
        if (hipGetDevice(&dev) != hipSuccess || hipDeviceGetAttribute(&cus, hipDeviceAttributeMultiprocessorCount, dev) != hipSuccess) { grid = -1; return; }
        if (hipFuncSetAttribute((const void*)mega, hipFuncAttributeMaxDynamicSharedMemorySize, LDS_BYTES) != hipSuccess) { fprintf(stderr, "kernel_launch: hipFuncSetAttribute failed\n"); grid = -1; return; }
        int per_cu = 0;
        if (hipOccupancyMaxActiveBlocksPerMultiprocessor(&per_cu, (const void*)mega, NWAVES * 64, LDS_BYTES) != hipSuccess || per_cu < 1) fprintf(stderr, "kernel_launch: occupancy query says %d\n", per_cu);
        (void)hipGetLastError();
        grid = cus;
    }
    if (grid < 0) return;
    unsigned char* ws = (unsigned char*)d_ws;
    Args a{};
    for (int i = 0; i < 32; ++i) a.in[i] = d_in[i];
    a.out = (float*)d_out; a.ws = ws;
    a.mask = (FAST_ATT ? MSK_ATT : 0) | (FAST_MEM ? MSK_MEM : 0) | (FAST_SSM ? MSK_SSM : 0) | (FAST_FFN ? MSK_FFN : 0) | (FAST_MOE ? MSK_MOE : 0);
    auto launch = [&](int lo, int hi) {
        hipMemsetAsync(ws + WS_CTL + 16384, 0, 16384, stream);
        a.lo = lo; a.hi = hi;
        hipLaunchKernelGGL(mega, dim3(grid), dim3(NWAVES * 64), LDS_BYTES, stream, a);
    };
    constexpr bool ALL_FAST = FAST_ATT && FAST_MEM && FAST_SSM && FAST_FFN && FAST_MOE;
    if (ALL_FAST) { launch(0, ST_END); return; }

    const float* x_in = (const float*)d_in[0]; const float* mem = (const float*)d_in[1]; const int* pos = (const int*)d_in[2];
    const float* norm_mix = (const float*)d_in[3]; const float* w_in = (const float*)d_in[4];
    const float* a_re = (const float*)d_in[5]; const float* a_im = (const float*)d_in[6]; const float* log_dt = (const float*)d_in[7];
    const float* b_re = (const float*)d_in[8]; const float* b_im = (const float*)d_in[9]; const float* c_re = (const float*)d_in[10]; const float* c_im = (const float*)d_in[11];
    const float* ssm_d = (const float*)d_in[12]; const float* w_glu = (const float*)d_in[13];
    const float* att_qn = (const float*)d_in[15]; const float* att_kn = (const float*)d_in[16];
    const float* norm_mem = (const float*)d_in[18]; const float* w_mem_kv = (const float*)d_in[19]; const float* mem_qn = (const float*)d_in[20]; const float* mem_kn = (const float*)d_in[21];
    const float* norm_ffn = (const float*)d_in[24];
    const float* ffn_g = (const float*)d_in[25]; const float* ffn_u = (const float*)d_in[26]; const float* ffn_d = (const float*)d_in[27];
    const float* moe_r = (const float*)d_in[28]; const float* moe_g = (const float*)d_in[29]; const float* moe_u = (const float*)d_in[30]; const float* moe_d = (const float*)d_in[31];
    float* out = (float*)d_out;
    float* bufH = (float*)(ws + WS_NAIVE);
    float* big = (float*)(ws + WS_NAIVE + 16 * MiB);
    float* gate = (float*)(ws + WS_NAIVE + 72 * MiB);
    const int R = 4096;
    launch(0, ST_LAYER0);
    for (int l = 0; l < 2; ++l) {
        const int base = ST_LAYER0 + l * ST_PER_LAYER;
        const float* xcur = (l == 0) ? x_in : out;
        const float* Win = w_in + (size_t)l * DM * INC;
        launch(base + 0, base + 6);
        if (!(FAST_ATT && FAST_MEM && FAST_SSM)) {
            for (int b = 0; b < 4; ++b) {
                hipLaunchKernelGGL(nv::k_rmsnorm, dim3(R * 64 / 256), dim3(256), 0, stream, xcur + (size_t)b * R * DM, norm_mix + l * DM, bufH, R);
                if (!FAST_SSM) {
                    float* U = big; float* Y = big + (size_t)R * 512; float* GA = big + (size_t)R * 1024; float* S = big + (size_t)R * 2048;
                    ngemm<0>(stream, bufH, DM, Win, INC, U, 512, R, 512, DM);
                    hipLaunchKernelGGL(nv::k_ssm, dim3(32), dim3(64), 0, stream, U, Y, a_re + l * 2048, a_im + l * 2048, log_dt + l * 32, b_re + l * 32768, b_im + l * 32768, c_re + l * 32768, c_im + l * 32768, ssm_d + l * 512);
                    ngemm<0>(stream, Y, 512, w_glu + (size_t)l * 512 * 1024, 1024, GA, 1024, R, 1024, 512);
                    hipLaunchKernelGGL(nv::k_glu, dim3(R * 512 / 256), dim3(256), 0, stream, GA, S, R * 512);
                    cvt(stream, S, ws + WS_CAT + (size_t)b * R * 1280 * 2, (size_t)R * 512, 512, 1280);
                }
                if (!FAST_ATT) {
                    float* QKVf = big; float* OGf = big + (size_t)R * 2304; float* AOf = big + (size_t)R * 3072; float* LSEf = big + (size_t)R * 3328;
                    ngemm<0>(stream, bufH, DM, Win + 512, INC, QKVf, 2304, R, 2304, DM);
                    hipLaunchKernelGGL((nv::k_headnorm<64, true>), dim3(R * 12 * 64 / 256), dim3(256), 0, stream, QKVf, 2304, 0, 12, R, att_qn + l * 64, pos + b * R);
                    hipLaunchKernelGGL((nv::k_headnorm<64, true>), dim3(R * 12 * 64 / 256), dim3(256), 0, stream, QKVf, 2304, 768, 12, R, att_kn + l * 64, pos + b * R);
                    hipLaunchKernelGGL(nv::k_dilattn, dim3(R * 12 * 64 / 256), dim3(256), 0, stream, QKVf, OGf, LSEf, R);
                    hipLaunchKernelGGL(nv::k_attmerge, dim3(R * 256 / 256), dim3(256), 0, stream, OGf, LSEf, AOf, R);
                    cvt(stream, AOf, ws + WS_CAT + ((size_t)b * R * 1280 + 512) * 2, (size_t)R * 256, 256, 1280);
                }
                if (!FAST_MEM) {
                    float* XQf = big; float* MOf = big + (size_t)R * 512; float* KVf = big + (size_t)R * 1024; float* MEMNf = KVf + 256 * 1024;
                    hipLaunchKernelGGL(nv::k_rmsnorm, dim3(256 * 64 / 256), dim3(256), 0, stream, mem + (size_t)b * 256 * DM, norm_mem + l * DM, MEMNf, 256);
                    ngemm<0>(stream, MEMNf, DM, w_mem_kv + (size_t)l * DM * 1024, 1024, KVf, 1024, 256, 1024, DM);
                    hipLaunchKernelGGL((nv::k_headnorm<128, false>), dim3(256 * 4 * 64 / 256), dim3(256), 0, stream, KVf, 1024, 0, 4, 256, mem_kn + l * 128, (const int*)nullptr);
                    ngemm<0>(stream, bufH, DM, Win + 2816, INC, XQf, 512, R, 512, DM);
                    hipLaunchKernelGGL((nv::k_headnorm<128, false>), dim3(R * 4 * 64 / 256), dim3(256), 0, stream, XQf, 512, 0, 4, R, mem_qn + l * 128, (const int*)nullptr);
                    hipLaunchKernelGGL(nv::k_memattn, dim3(R * 4 * 64 / 256), dim3(256), 0, stream, XQf, KVf, MOf, R);
                    cvt(stream, MOf, ws + WS_CAT + ((size_t)b * R * 1280 + 768) * 2, (size_t)R * 512, 512, 1280);
                }
            }
        }
        launch(base + 6, base + 11);
        if (l == 0) {
            if (FAST_FFN) launch(base + 11, base + 14);
            else {
                for (int b = 0; b < 4; ++b) {
                    float* ob = out + (size_t)b * R * DM;
                    hipLaunchKernelGGL(nv::k_rmsnorm, dim3(R * 64 / 256), dim3(256), 0, stream, ob, norm_ffn, bufH, R);
                    ngemm<0>(stream, bufH, DM, ffn_g, DFF, big, DFF, R, DFF, DM);
                    ngemm<3>(stream, bufH, DM, ffn_u, DFF, big, DFF, R, DFF, DM);
                    ngemm<2>(stream, big, DFF, ffn_d, DM, ob, DM, R, DM, DFF, ob, DM);
                }
                launch(base + 13, base + 14);
            }
        } else {
            if (FAST_MOE) launch(base + 11, base + 16);
            else {
                for (int b = 0; b < 4; ++b) {
                    float* ob = out + (size_t)b * R * DM;
                    hipLaunchKernelGGL(nv::k_rmsnorm, dim3(R * 64 / 256), dim3(256), 0, stream, ob, norm_ffn + DM, bufH, R);
                    hipLaunchKernelGGL(nv::k_router, dim3(R * 64 / 256), dim3(256), 0, stream, bufH, moe_r, gate, R);
                    for (int e = 0; e < NE; ++e) {
                        ngemm<0>(stream, bufH, DM, moe_g + (size_t)e * DM * DFE, DFE, big, DFE, R, DFE, DM);
                        ngemm<3>(stream, bufH, DM, moe_u + (size_t)e * DM * DFE, DFE, big, DFE, R, DFE, DM);
                        ngemm<4>(stream, big, DFE, moe_d + (size_t)e * DFE * DM, DM, ob, DM, R, DM, DFE, gate + e, 8);
                    }
                }
            }
        }
    }
}
```
